# Optimizing an MI355X kernel written in HIP

```python
import math
import jax
import jax.numpy as jnp
from jax import lax
import numpy as np

D_MODEL = 2048
BATCH = 1
SEQ = 16384
DEPTH = 2

CHUNK = 64
D_MIX = D_MODEL
GROUP_W = D_MIX // 4
S5_GROUP_CH = 16
S5_GROUPS = GROUP_W // S5_GROUP_CH
S5_STATE = 64
CONV_W = 3
SGU_BLK = 128
SGU_HEADS = 4
SGU_HEAD_DIM = GROUP_W // SGU_HEADS
DIFF_HEADS = 4
DIFF_QK_DIM = GROUP_W // (2 * DIFF_HEADS)
DIFF_V_DIM = 2 * DIFF_QK_DIM
QBLK = 128
NUM_BUCKETS = 32
MAX_DISTANCE = 128
N_EXPERTS = 64
TOP_K = 8
N_EXPERT_GROUPS = 8
TOPK_GROUPS = 4
D_EXPERT = D_MODEL // 4
D_SHARED = D_EXPERT
ROUTED_SCALE = 2.5
MOE_BLK = 128
PROJ_W = 9 * GROUP_W
DN_ALPHA = (2 * DEPTH) ** 0.25
DN_BETA = (8 * DEPTH) ** -0.25
EPS = 1e-5
NEG_INF = -1e30

kernel_name = 'hybrid_chunk_causal_s5_conv_sgu_diffattn_moe'


def layer_norm(x, g, b):
    xf = x.astype(jnp.float32)
    mu = jnp.mean(xf, -1, keepdims=True)
    var = jnp.mean(jnp.square(xf - mu), -1, keepdims=True)
    return ((xf - mu) * lax.rsqrt(var + EPS) * g.astype(jnp.float32) + b.astype(jnp.float32)).astype(x.dtype)


def rms_norm(x, g):
    xf = x.astype(jnp.float32)
    return (xf * lax.rsqrt(jnp.mean(jnp.square(xf), -1, keepdims=True) + EPS) * g.astype(jnp.float32)).astype(x.dtype)


def _ssm_combine(left, right):
    a_l, b_l = left
    a_r, b_r = right
    return a_r * a_l, a_r * b_l + b_r


def s5_mixer(u, lam_re, lam_im, log_dt, b_re, b_im, c_re, c_im, d, w_glu):
    Bt, L, _ = u.shape
    f32 = jnp.float32
    uf = u.astype(f32).reshape(Bt, L, S5_GROUPS, S5_GROUP_CH)
    dt = jnp.exp(log_dt.astype(f32))[:, None]
    lam = lax.complex(lam_re.astype(f32), lam_im.astype(f32))
    lam_bar = jnp.exp(lam * dt)
    b = lax.complex(b_re.astype(f32), b_im.astype(f32))
    b_bar = ((lam_bar - 1.0) / lam)[..., None] * b
    bu = jnp.einsum('gph,blgh->blgp', b_bar, uf.astype(jnp.complex64))
    a = jnp.broadcast_to(lam_bar, bu.shape)
    _, states = lax.associative_scan(_ssm_combine, (a, bu), axis=1)
    c = lax.complex(c_re.astype(f32), c_im.astype(f32))
    y = jnp.real(jnp.einsum('ghp,blgp->blgh', c, states))
    y = y + d.astype(f32).reshape(S5_GROUPS, S5_GROUP_CH) * uf
    y = jax.nn.gelu(y.reshape(Bt, L, GROUP_W))
    y = y * jax.nn.sigmoid(y @ w_glu.astype(f32))
    return y.astype(u.dtype)


def short_conv_mixer(bg, cg, h, conv_w):
    L = h.shape[1]
    z = cg * h
    zp = jnp.pad(z, ((0, 0), (CONV_W - 1, 0), (0, 0)))
    conv = sum(conv_w[k] * zp[:, k:k + L] for k in range(CONV_W))
    return bg * conv


def sgu_mixer(u, v, ln_g, ln_b, w_s, b_s):
    Bt, L, _ = v.shape
    u = jax.nn.gelu(u)
    v = layer_norm(jax.nn.gelu(v), ln_g, ln_b)
    vb = v.reshape(Bt, L // SGU_BLK, SGU_BLK, SGU_HEADS, SGU_HEAD_DIM)
    pos = jnp.arange(SGU_BLK)
    mask = (pos[None, :] // CHUNK) <= (pos[:, None] // CHUNK)
    ws = jnp.where(mask[None], w_s, 0.0)
    mixed = jnp.einsum('hij,bnjhc->bnihc', ws, vb) + b_s.T[:, :, None]
    return u * mixed.reshape(Bt, L, GROUP_W)


def t5_bucket(rel):
    half = NUM_BUCKETS // 2
    ret = jnp.where(rel > 0, half, 0)
    n = jnp.abs(rel)
    max_exact = half // 2
    large = max_exact + (jnp.log(jnp.maximum(n, 1).astype(jnp.float32) / max_exact)
                         / math.log(MAX_DISTANCE / max_exact) * (half - max_exact)).astype(jnp.int32)
    large = jnp.minimum(large, half - 1)
    return ret + jnp.where(n < max_exact, n, large)


def diff_attention(q, k, v, lq1, lk1, lq2, lk2, subln_g, rel_bias, lambda_init):
    Bt, L = q.shape[0], q.shape[1]
    f32 = jnp.float32
    nqb = L // QBLK
    lam = (jnp.exp(jnp.sum(lq1.astype(f32) * lk1.astype(f32)))
           - jnp.exp(jnp.sum(lq2.astype(f32) * lk2.astype(f32))) + lambda_init)
    kpos = jnp.arange(L)
    k_chunk = kpos // CHUNK
    qb = jnp.moveaxis((q * DIFF_QK_DIM ** -0.5).reshape(Bt, nqb, QBLK, DIFF_HEADS, 2, DIFF_QK_DIM), 1, 0)

    def block(args):
        qblk, bi = args
        qpos = bi * QBLK + jnp.arange(QBLK)
        bias = jnp.transpose(rel_bias[t5_bucket(kpos[None, :] - qpos[:, None])], (2, 0, 1)).astype(f32)
        mask = k_chunk[None, :] <= (qpos // CHUNK)[:, None]
        s = jnp.einsum('bqhmd,bkhmd->bmhqk', qblk, k).astype(f32) + bias
        s = jnp.where(mask, s, NEG_INF)
        p = jax.nn.softmax(s, axis=-1)
        attn = p[:, 0] - lam * p[:, 1]
        return jnp.einsum('bhqk,bkhe->bqhe', attn.astype(v.dtype), v)

    out = lax.map(block, (qb, jnp.arange(nqb)))
    out = jnp.moveaxis(out, 0, 1).reshape(Bt, L, DIFF_HEADS, DIFF_V_DIM)
    out = rms_norm(out, subln_g) * (1.0 - lambda_init)
    return out.reshape(Bt, L, DIFF_HEADS * DIFF_V_DIM)


def moe_ffn(h, router_w, router_bias, w_gu, w_down, sh_gu, sh_down):
    Bt, L, D = h.shape
    T = Bt * L
    f32 = jnp.float32
    xt = h.reshape(T, D)
    scores = jax.nn.sigmoid((xt @ router_w).astype(f32))
    sel = scores + router_bias.astype(f32)
    grp = sel.reshape(T, N_EXPERT_GROUPS, N_EXPERTS // N_EXPERT_GROUPS)
    grp_score = jnp.sum(lax.top_k(grp, 2)[0], axis=-1)
    _, top_groups = lax.top_k(grp_score, TOPK_GROUPS)
    group_mask = jnp.any(top_groups[..., None] == jnp.arange(N_EXPERT_GROUPS), axis=1)
    expert_mask = jnp.repeat(group_mask, N_EXPERTS // N_EXPERT_GROUPS, axis=1)
    _, top_idx = lax.top_k(jnp.where(expert_mask, sel, -jnp.inf), TOP_K)
    top_w = jnp.take_along_axis(scores, top_idx, axis=1)
    top_w = top_w / (jnp.sum(top_w, -1, keepdims=True) + 1e-20) * ROUTED_SCALE

    A = T * TOP_K
    e_flat = top_idx.reshape(A)
    tok_flat = jnp.broadcast_to(jnp.arange(T, dtype=jnp.int32)[:, None], (T, TOP_K)).reshape(A)
    w_flat = top_w.reshape(A)
    order = jnp.argsort(e_flat)
    e_s, tok_s, w_s = e_flat[order], tok_flat[order], w_flat[order]
    counts = jnp.zeros((N_EXPERTS,), jnp.int32).at[e_flat].add(1)
    starts = jnp.cumsum(counts) - counts
    padded = (counts + MOE_BLK - 1) // MOE_BLK * MOE_BLK
    pends = jnp.cumsum(padded)
    pstarts = pends - padded
    dest = pstarts[e_s] + (jnp.arange(A) - starts[e_s])
    NB = -(-A // MOE_BLK) + N_EXPERTS
    row_tok = jnp.full((NB * MOE_BLK,), T, jnp.int32).at[dest].set(tok_s)
    row_w = jnp.zeros((NB * MOE_BLK,), f32).at[dest].set(w_s)
    block_e = jnp.minimum(jnp.searchsorted(pends, jnp.arange(NB) * MOE_BLK, side='right'), N_EXPERTS - 1)
    x_pad = jnp.concatenate([xt, jnp.zeros((1, D), xt.dtype)], axis=0)

    def body(acc, blk):
        tok, w, e = blk
        xs = x_pad[tok]
        g, u = jnp.split(xs @ w_gu[e], 2, axis=-1)
        y = (jax.nn.silu(g) * u) @ w_down[e]
        return acc.at[tok].add(y * w[:, None].astype(y.dtype)), None

    acc, _ = lax.scan(body, jnp.zeros((T + 1, D), xt.dtype),
                      (row_tok.reshape(NB, MOE_BLK), row_w.reshape(NB, MOE_BLK), block_e))
    g, u = jnp.split(xt @ sh_gu, 2, axis=-1)
    shared = (jax.nn.silu(g) * u) @ sh_down
    return (acc[:T] + shared).reshape(Bt, L, D)


def setup_inputs(seed: int = 0) -> dict:
    key = jax.random.key(seed)
    ks = iter(jax.random.split(key, 40))
    f32 = jnp.float32

    def nrm(shape, scale):
        return jax.random.normal(next(ks), shape, f32) * scale

    L, G, P, H = DEPTH, S5_GROUPS, S5_STATE, S5_GROUP_CH
    n = jnp.arange(P, dtype=f32)
    return {
        'x': nrm((BATCH, SEQ, D_MODEL), 1.0),
        'w_in': nrm((L, D_MODEL, PROJ_W), D_MODEL ** -0.5),
        'w_out': nrm((L, D_MIX, D_MODEL), D_MIX ** -0.5 * DN_BETA),
        'mix_norm_g': 1.0 + nrm((L, 3 * GROUP_W), 0.1),
        's5_lambda_re': -0.5 + nrm((L, G, P), 0.01),
        's5_lambda_im': math.pi * n + nrm((L, G, P), 0.01),
        's5_log_dt': jax.random.uniform(next(ks), (L, G), f32, math.log(1e-3), math.log(1e-1)),
        's5_b_re': nrm((L, G, P, H), (2 * H) ** -0.5),
        's5_b_im': nrm((L, G, P, H), (2 * H) ** -0.5),
        's5_c_re': nrm((L, G, H, P), (2 * P) ** -0.5),
        's5_c_im': nrm((L, G, H, P), (2 * P) ** -0.5),
        's5_d': nrm((L, GROUP_W), 1.0),
        's5_w_glu': nrm((L, GROUP_W, GROUP_W), GROUP_W ** -0.5),
        'conv_w': nrm((L, CONV_W, GROUP_W), CONV_W ** -0.5),
        'sgu_ln_g': 1.0 + nrm((L, GROUP_W), 0.1),
        'sgu_ln_b': nrm((L, GROUP_W), 0.02),
        'sgu_w': nrm((L, SGU_HEADS, SGU_BLK, SGU_BLK), SGU_BLK ** -0.5),
        'sgu_b': 1.0 + nrm((L, SGU_HEADS, SGU_BLK), 0.1),
        'diff_lq1': nrm((L, DIFF_QK_DIM), 0.1),
        'diff_lk1': nrm((L, DIFF_QK_DIM), 0.1),
        'diff_lq2': nrm((L, DIFF_QK_DIM), 0.1),
        'diff_lk2': nrm((L, DIFF_QK_DIM), 0.1),
        'diff_subln_g': 1.0 + nrm((L, DIFF_V_DIM), 0.1),
        'rel_bias': nrm((NUM_BUCKETS, DIFF_HEADS), 0.5),
        'ln1_g': 1.0 + nrm((L, D_MODEL), 0.1),
        'ln1_b': nrm((L, D_MODEL), 0.02),
        'router_w': nrm((L, D_MODEL, N_EXPERTS), D_MODEL ** -0.5),
        'router_bias': nrm((L, N_EXPERTS), 0.01),
        'moe_w_gu': nrm((L, N_EXPERTS, D_MODEL, 2 * D_EXPERT), D_MODEL ** -0.5),
        'moe_w_down': nrm((L, N_EXPERTS, D_EXPERT, D_MODEL), D_EXPERT ** -0.5 * DN_BETA),
        'shared_w_gu': nrm((L, D_MODEL, 2 * D_SHARED), D_MODEL ** -0.5),
        'shared_w_down': nrm((L, D_SHARED, D_MODEL), D_SHARED ** -0.5 * DN_BETA),
        'ln2_g': 1.0 + nrm((L, D_MODEL), 0.1),
        'ln2_b': nrm((L, D_MODEL), 0.02),
    }


def reference(x, w_in, w_out, mix_norm_g, s5_lambda_re, s5_lambda_im, s5_log_dt, s5_b_re, s5_b_im,
              s5_c_re, s5_c_im, s5_d, s5_w_glu, conv_w, sgu_ln_g, sgu_ln_b, sgu_w, sgu_b,
              diff_lq1, diff_lk1, diff_lq2, diff_lk2, diff_subln_g, rel_bias, ln1_g, ln1_b,
              router_w, router_bias, moe_w_gu, moe_w_down, shared_w_gu, shared_w_down, ln2_g, ln2_b):
    Bt, L, _ = x.shape
    split_points = [GROUP_W * i for i in range(1, 9)]
    for l in range(DEPTH):
        proj = x @ w_in[l]
        s5_u, cb, cc, ch, su, sv, q, k, v = jnp.split(proj, split_points, axis=-1)
        a_out = s5_mixer(s5_u, s5_lambda_re[l], s5_lambda_im[l], s5_log_dt[l], s5_b_re[l], s5_b_im[l],
                         s5_c_re[l], s5_c_im[l], s5_d[l], s5_w_glu[l])
        b_out = short_conv_mixer(cb, cc, ch, conv_w[l])
        c_out = sgu_mixer(su, sv, sgu_ln_g[l], sgu_ln_b[l], sgu_w[l], sgu_b[l])
        lambda_init = 0.8 - 0.6 * math.exp(-0.3 * l)
        d_out = diff_attention(q.reshape(Bt, L, DIFF_HEADS, 2, DIFF_QK_DIM),
                               k.reshape(Bt, L, DIFF_HEADS, 2, DIFF_QK_DIM),
                               v.reshape(Bt, L, DIFF_HEADS, DIFF_V_DIM),
                               diff_lq1[l], diff_lk1[l], diff_lq2[l], diff_lk2[l], diff_subln_g[l],
                               rel_bias, lambda_init)
        abc = jnp.concatenate([a_out, b_out, c_out], axis=-1).reshape(Bt, L, 3, GROUP_W)
        abc = rms_norm(abc, mix_norm_g[l].reshape(3, GROUP_W)).reshape(Bt, L, 3 * GROUP_W)
        mix = jnp.concatenate([abc, d_out], axis=-1) @ w_out[l]
        x = layer_norm(DN_ALPHA * x + mix, ln1_g[l], ln1_b[l])
        ffn = moe_ffn(x, router_w[l], router_bias[l], moe_w_gu[l], moe_w_down[l],
                      shared_w_gu[l], shared_w_down[l])
        x = layer_norm(DN_ALPHA * x + ffn, ln2_g[l], ln2_b[l])
    return x
```

```cpp
#include <hip/hip_runtime.h>
#include <cstdio>
#include <cstdint>

#ifndef REPMASK
#define REPMASK 0
#endif
#ifndef DOWN_FP8
#define DOWN_FP8 1
#endif
#ifndef FP8_FIRST
#define FP8_FIRST 0
#endif
#ifndef MK_ONE_LAUNCH
#define MK_ONE_LAUNCH 1
#endif

#define GAS __attribute__((address_space(1)))
#define LAS __attribute__((address_space(3)))
typedef unsigned short bf16;
typedef short bf16x8 __attribute__((ext_vector_type(8)));
typedef short s16x4 __attribute__((ext_vector_type(4)));
typedef float f32x2 __attribute__((ext_vector_type(2)));
typedef float f32x4 __attribute__((ext_vector_type(4)));
typedef float f32x16 __attribute__((ext_vector_type(16)));
typedef unsigned u32x2 __attribute__((ext_vector_type(2)));
typedef unsigned u32x4 __attribute__((ext_vector_type(4)));
typedef GAS unsigned gu32;
typedef int v8i_t __attribute__((ext_vector_type(8)));
typedef short s16x16_t __attribute__((ext_vector_type(16)));

constexpr int T = 16384, D = 2048, PW = 4608, GW = 512, NEXP = 64, NE1 = 65, DEXP = 512, TOPK = 8, DEPTH = 2;
constexpr int RMAX = 163840;
constexpr int C_S5U = 0, C_CB = 512, C_CC = 1024, C_CH = 1536, C_SU = 2048, C_SV = 2560, C_Q = 3072, C_K = 3584, C_V = 4096;
constexpr float ALPHA = 1.4142135623730951f, LOG2E = 1.4426950408889634f, QSCALE = 0.125f * LOG2E, EPS = 1e-5f;
constexpr int NWAVES = 8, NTHR = 512;

constexpr size_t MiB = 1u << 20;
constexpr size_t WS_CTL = 0, CTL_ZERO_BYTES = 1 * MiB;
constexpr size_t WS_ETAB = 1 * MiB;
constexpr size_t WS_CNT = WS_ETAB + 4096;
constexpr size_t WS_SELE = 2 * MiB;
constexpr size_t WS_SELW = WS_SELE + (size_t)T * 8 * 4;
constexpr size_t WS_SELR = WS_SELW + (size_t)T * 8 * 4;
constexpr size_t WS_SLOT = WS_SELR + (size_t)T * 8 * 4;
constexpr size_t WS_ROWTOK = WS_SLOT + (size_t)T * 8 * 4;
constexpr size_t WS_S5E = 6 * MiB;
constexpr size_t WS_S5TAB = 10 * MiB;
constexpr size_t S5TAB_STRIDE = 512 * 1024, S5T_ABAR = 0, S5T_AL = 16384, S5T_BMAT = 32768, S5T_CMAT = 32768 + 131072;
constexpr int CM_PITCH = 144;
constexpr size_t WS_SGUW = 11 * MiB;
constexpr size_t WS_RT = 12 * MiB;
constexpr size_t WS_WIN = 16 * MiB;
constexpr size_t WS_WOUT = WS_WIN + (size_t)2 * PW * D * 2;
constexpr size_t WS_WGLU = WS_WOUT + (size_t)2 * D * D * 2;
constexpr size_t WS_WGU = WS_WGLU + (size_t)2 * GW * GW * 2;
constexpr size_t WS_WDN = WS_WGU + (size_t)2 * NE1 * 1024 * D * 2;
constexpr size_t WS_XB = WS_WDN + (size_t)2 * NE1 * D * DEXP * 2;
constexpr size_t WS_PROJ = WS_XB + (size_t)T * D * 2;
constexpr size_t WS_MIX = WS_PROJ + (size_t)T * PW * 2;
constexpr size_t WS_YF = WS_MIX + (size_t)T * D * 2;
constexpr size_t WS_X1F = WS_YF + (size_t)T * D * 4;
constexpr size_t WS_X1B = WS_X1F + (size_t)T * D * 4;
constexpr size_t WS_X1L = WS_X1B + (size_t)T * D * 2;
constexpr size_t WS_H = WS_X1L + (size_t)T * D * 2;
constexpr size_t WS_YS = WS_H + (size_t)RMAX * DEXP * 2;
constexpr size_t WS_S5IN = WS_YS + (size_t)RMAX * D * 2;
constexpr size_t WS_END = WS_S5IN + 4 * MiB;
static_assert(WS_ROWTOK + (size_t)RMAX * 4 <= WS_S5E, "ws map");
static_assert(WS_WIN % 256 == 0 && WS_WOUT % 256 == 0 && WS_WGU % 256 == 0 && WS_XB % 256 == 0 && WS_YS % 256 == 0, "ws align");

constexpr int CW_TMO = 0;
constexpr int CW_BAR = 4096;

constexpr int LDS_MISC = 147456 - 256;
constexpr int LDS_BYTES = 147456;

#define RLX_AGENT __ATOMIC_RELAXED, __HIP_MEMORY_SCOPE_AGENT
__device__ __forceinline__ unsigned hw_pk_bf16(float lo, float hi) { typedef __bf16 bf16x2_t __attribute__((ext_vector_type(2))); f32x2 v = {lo, hi}; bf16x2_t b = __builtin_convertvector(v, bf16x2_t); return __builtin_bit_cast(unsigned, b); }
__device__ __forceinline__ unsigned f2bf(float f) { return hw_pk_bf16(f, 0.f) & 0xffffu; }
__device__ __forceinline__ float bf2f(unsigned b) { return __builtin_bit_cast(float, b << 16); }
__device__ __forceinline__ unsigned pk2(float lo, float hi) { return hw_pk_bf16(lo, hi); }
__device__ __forceinline__ unsigned pk4_fp8(float a, float b, float c, float d) { int w = __builtin_amdgcn_cvt_pk_fp8_f32(a, b, 0, false); w = __builtin_amdgcn_cvt_pk_fp8_f32(c, d, w, true); return (unsigned)w; }
constexpr float YS8SCALE = 16.0f;
constexpr float W8SCALE = 32.0f;
__device__ __forceinline__ float bflo(unsigned w) { return __builtin_bit_cast(float, w << 16); }
__device__ __forceinline__ float bfhi(unsigned w) { return __builtin_bit_cast(float, w & 0xffff0000u); }
__device__ __forceinline__ int lane_id() { unsigned z = 0u; asm volatile("" : "+v"(z)); return (int)__builtin_amdgcn_mbcnt_hi(~0u, __builtin_amdgcn_mbcnt_lo(~0u, z)); }
__device__ __forceinline__ float shfl_xor_l(float v, int lane, int m) { return __builtin_bit_cast(float, __builtin_amdgcn_ds_bpermute((lane ^ m) << 2, __builtin_bit_cast(int, v))); }
__device__ __forceinline__ void swap32(float v, float& r0, float& r1) { float a = v, b = v;
    asm volatile("s_nop 1\n\tv_permlane32_swap_b32 %0, %1" : "+v"(a), "+v"(b)); r0 = a; r1 = b; }
__device__ __forceinline__ float swap_sum(float v) { float r0, r1; swap32(v, r0, r1); return r0 + r1; }
__device__ __forceinline__ float swap_max(float v) { float r0, r1; swap32(v, r0, r1); return fmaxf(r0, r1); }
__device__ __forceinline__ float partner32(float v, int hi) { float r0, r1; swap32(v, r0, r1); return hi ? r0 : r1; }
template <int CTRL> __device__ __forceinline__ float dpp_mov(float v) { return __builtin_bit_cast(float, __builtin_amdgcn_update_dpp(0, __builtin_bit_cast(int, v), CTRL, 0xf, 0xf, false)); }
__device__ __forceinline__ float wave_sum(float v) {
    v += dpp_mov<0xB1>(v); v += dpp_mov<0x4E>(v); v += dpp_mov<0x141>(v); v += dpp_mov<0x140>(v);
    v = swap_sum(v);
    const int vi = __builtin_bit_cast(int, v);
    return __builtin_bit_cast(float, __builtin_amdgcn_readlane(vi, 0)) + __builtin_bit_cast(float, __builtin_amdgcn_readlane(vi, 16));
}
__device__ __forceinline__ float gelu_tanh(float x) {
    const float u = 0.7978845608028654f * (x + 0.044715f * x * x * x);
    const float e = __expf(2.0f * u);
    return x - x * __builtin_amdgcn_rcpf(e + 1.0f);
}
__device__ __forceinline__ float sigmoidf_(float x) { return __builtin_amdgcn_rcpf(1.0f + __expf(-x)); }
__device__ __forceinline__ float sigmoid_div(float x) { return 1.0f / (1.0f + __expf(-x)); }
__device__ __forceinline__ int crow(int r, int hi) { return (r & 3) + 8 * (r >> 2) + 4 * hi; }

#define XB_TMO      128
#define XB_XCNT(j)  (256  + 64 * (j))
#define XB_XSUB(j)  (1280 + 64 * (j))
#define XB_XGEN(j)  (2304 + 64 * (j))
#define XB_TOP      3328
#define XB_TOPGEN   3392
#define XCD_BAR_WORDS 3456
#define XB_SPIN_CAP (1u << 22)
__device__ __forceinline__ unsigned xb_ld(unsigned* p)              { return __hip_atomic_load(p, __ATOMIC_RELAXED, __HIP_MEMORY_SCOPE_AGENT); }
__device__ __forceinline__ unsigned xb_add(unsigned* p, unsigned v) { return __hip_atomic_fetch_add(p, v, __ATOMIC_RELAXED, __HIP_MEMORY_SCOPE_AGENT); }
__device__ __forceinline__ unsigned xb_xcc_id() { return (unsigned)__builtin_amdgcn_s_getreg((3 << 11) | 20) & 0xFu; }
#define XB_SPIN(cond, bar) do { unsigned _sp = 0; while (cond) { __builtin_amdgcn_s_sleep(1); \
    if ((++_sp & 255u) == 0u) { if (xb_ld(&(bar)[XB_TMO])) break; if (_sp > XB_SPIN_CAP) { atomicAdd(&(bar)[XB_TMO], 1u); break; } } } } while (0)
struct XcdBarrier { unsigned* bar; unsigned x; volatile LAS unsigned* st; int wave; };
__device__ __forceinline__ XcdBarrier xcd_barrier_post(unsigned* bar, volatile LAS unsigned* st) {
    XcdBarrier b; b.bar = bar; b.x = xb_xcc_id(); b.st = st;
    if (threadIdx.x == 0) (void)xb_add(&bar[XB_XCNT(b.x)], 1u);
    b.wave = __builtin_amdgcn_readfirstlane(threadIdx.x >> 6);
    return b;
}
__device__ __forceinline__ void xcd_barrier_complete(unsigned* bar, unsigned x, unsigned& nloc, unsigned& nx) {
    const unsigned G = gridDim.x * gridDim.y * gridDim.z;
    unsigned sum, cnt, mine, sp = 0u;
    for (;;) {
        sum = 0u; cnt = 0u; mine = 0u;
#pragma unroll
        for (unsigned j = 0; j < 16; ++j) { const unsigned c = xb_ld(&bar[XB_XCNT(j)]); sum += c; cnt += (c > 0u) ? 1u : 0u; mine = (j == x) ? c : mine; }
        if (sum == G) break;
        __builtin_amdgcn_s_sleep(1);
        if ((++sp & 255u) == 0u) { if (xb_ld(&bar[XB_TMO])) break; if (sp > XB_SPIN_CAP) { atomicAdd(&bar[XB_TMO], 1u); break; } }
    }
    nloc = mine > 0u ? mine : 1u; nx = cnt > 0u ? cnt : 1u;
}
__device__ __forceinline__ void xcd_barrier(const XcdBarrier& b) {
    asm volatile("s_waitcnt vmcnt(0)" ::: "memory");
    __syncthreads();
    if (b.wave == 0 && lane_id() == 0) {
        unsigned* bar = b.bar; asm volatile("" : "+s"(bar));
        __builtin_amdgcn_s_waitcnt(0);
        unsigned nloc = b.st[0], nx = b.st[1];
        if (nloc == 0u) { xcd_barrier_complete(bar, b.x, nloc, nx); b.st[0] = nloc; b.st[1] = nx; }
        const unsigned old = xb_add(&bar[XB_XSUB(b.x)], 1u);
        const unsigned gen = old / nloc;
        if (old + 1u == (gen + 1u) * nloc) {
            __builtin_amdgcn_fence(__ATOMIC_RELEASE, "agent");
            asm volatile("s_waitcnt vmcnt(0)" ::: "memory");
            const unsigned og = xb_add(&bar[XB_TOP], 1u);
            const unsigned tg = og / nx;
            if (og + 1u == (tg + 1u) * nx) xb_add(&bar[XB_TOPGEN], 1u);
            else XB_SPIN(xb_ld(&bar[XB_TOPGEN]) == tg, bar);
            __builtin_amdgcn_fence(__ATOMIC_ACQUIRE, "agent");
            xb_add(&bar[XB_XGEN(b.x)], 1u);
            asm volatile("s_waitcnt vmcnt(0)" ::: "memory");
        } else {
            XB_SPIN(xb_ld(&bar[XB_XGEN(b.x)]) == gen, bar);
            __builtin_amdgcn_fence(__ATOMIC_ACQUIRE, "agent");
            asm volatile("s_waitcnt vmcnt(0)" ::: "memory");
        }
    }
    __syncthreads();
}

struct Args { const float* in[34]; float* out; unsigned char* ws; int ph_lo, ph_hi; };
struct Frame {
    LAS unsigned char* lds;
    int wave, vcu, G;
};

namespace gm {
constexpr int BM = 256, BK = 64, HALF = 128;
struct Unit { int pm, pn, e; };
struct Gemm { const void* A; const void* Bt; int K; const int* rowidx; size_t b_estride; };
__host__ __device__ __forceinline__ int perm32(int rho) { const int n = rho >> 4, i = rho & 15; return 8 * (i >> 2) + 4 * n + (i & 3); }

struct DenseOrder {
    int nM, nN, nwg, G, c;
    __device__ void init(int M, int N, int G_, int c_) { nM = M / BM; nN = N / BM; nwg = nM * nN; G = G_; c = c_; }
    __device__ bool next(int i, Unit& u) const {
        const long L = (long)i * G + c; if (L >= nwg) return false;
        int wgid = (int)L; { const int q = nwg / 8, r = nwg % 8, xcd = wgid % 8, off = wgid / 8; wgid = (xcd < r ? xcd * (q + 1) : r * (q + 1) + (xcd - r) * q) + off; }
        const int WGM = 8, nig = WGM * nN, gid = wgid / nig, fm = gid * WGM, gsz = (nM - fm) < WGM ? (nM - fm) : WGM;
        u.pm = fm + ((wgid % nig) % gsz); u.pn = (wgid % nig) / gsz; u.e = 0; return true;
    }
};
struct GroupOrder {
    const LAS int* tp; int NT, G, vcu; mutable int ecur;
    __device__ bool next(int i, Unit& u) const {
        const int L = i * G + vcu; const int total = tp[NE1] * NT; if (L >= total) return false;
        const int tile = L / NT; u.pn = L % NT; u.pm = tile;
        int e = ecur;
        while (tile >= tp[e + 1]) ++e;
        ecur = e; u.e = e; return true;
    }
};

constexpr int HTB = HALF * BK * 2, STAGE_BYTES = 8 * HTB;
__host__ __device__ __forceinline__ int lds_byte(int r, int c) { const int st = (r >> 4) * 2 + (c >> 5), rr = r & 15, cc = c & 31, ob = rr * 64 + cc * 2; return st * 1024 + (ob ^ (((ob >> 9) & 1) << 5)); }
__host__ __device__ __forceinline__ void stage_rc(int b, int& R, int& C) { const int st = b / 1024, sb = b % 1024, swz = sb ^ (((sb >> 9) & 1) << 5); R = (st >> 1) * 16 + swz / 64; C = (st & 1) * 32 + (swz % 64) / 2; }

template <class Epi, class Sched, bool GATHER, bool FP8 = false, bool ALIGN = true>
__device__ __forceinline__ void gemm_phase(LAS unsigned char* lds, int wave, const Gemm g, const Sched& S, const Epi& E) {
    int lane = lane_id(); asm volatile("" : "+v"(lane));
    const int wid = wave, tid = wid * 64 + lane, wr = wid >> 2, wc = wid & 3, fr = lane & 15, fq = lane >> 4;
    const int K = g.K * (FP8 ? 1 : 2), nt = K / 128;
    int Rr[2], Cc[2]; unsigned voffB0[2], voffB1[2];
#pragma unroll
    for (int i = 0; i < 2; ++i) { int R, C; stage_rc(tid * 16 + i * 8192, R, C); Rr[i] = R; Cc[i] = 2 * C;
        int r0, r1;
        if constexpr (Epi::WIDE) { const int rho = R & 31, q = 16 * ((rho & 15) >> 2) + 4 * (rho >> 4) + (rho & 3); r0 = 64 * (R >> 5) + q; r1 = r0 + 8; }
        else { const int Rb = Epi::PERM ? ((R & ~31) + perm32(R & 31)) : R; r0 = Rb; r1 = HALF + Rb; }
        voffB0[i] = (unsigned)(r0 * K + 2 * C); voffB1[i] = (unsigned)(r1 * K + 2 * C); }
    const size_t kstep = 128, hstep = (size_t)HALF * K, tstep = 2 * hstep;
    const unsigned ldsw = (unsigned)wid * 1024u;
    const int aoff = lds_byte(wr * 64 + fr, fq * 8), boff = lds_byte(wc * 32 + fr, fq * 8);
    constexpr int KOFF = 1024;
#define PG8_SA(b, h) (((b) * 2 + (h)) * HTB)
#define PG8_SB(b, h) ((4 + (b) * 2 + (h)) * HTB)
#define PG8_STAGE(bufoff, gbase, voff) do { _Pragma("unroll") for (int _i = 0; _i < 2; ++_i) \
        __builtin_amdgcn_global_load_lds((const unsigned*)((const char*)(gbase) + (voff)[_i]), (LAS unsigned*)(lds + (bufoff) + ldsw + _i * 8192), 16, 0, 0); } while (0)
#define PG8_LDA(dst, b, h) do { _Pragma("unroll") for (int m = 0; m < 4; ++m) _Pragma("unroll") for (int k = 0; k < 2; ++k) dst[m][k] = *(const LAS bf16x8*)(lds + PG8_SA(b, h) + aoff + m * 2048 + k * KOFF); } while (0)
#define PG8_LDB(dst, b, h) do { _Pragma("unroll") for (int n = 0; n < 2; ++n) _Pragma("unroll") for (int k = 0; k < 2; ++k) dst[n][k] = *(const LAS bf16x8*)(lds + PG8_SB(b, h) + boff + n * 2048 + k * KOFF); } while (0)
#define PG8_CAT(x) __builtin_bit_cast(v8i_t, __builtin_shufflevector((x)[0], (x)[1], 0, 1, 2, 3, 4, 5, 6, 7, 8, 9, 10, 11, 12, 13, 14, 15))
#define PG8_MMA(ai, bj, At, Bt) do { __builtin_amdgcn_s_setprio(1); _Pragma("unroll") for (int m = 0; m < 4; ++m) _Pragma("unroll") for (int n = 0; n < 2; ++n) { \
        if constexpr (FP8) acc[ai][bj][m][n] = __builtin_amdgcn_mfma_scale_f32_16x16x128_f8f6f4(PG8_CAT(Bt[n]), PG8_CAT(At[m]), acc[ai][bj][m][n], 0, 0, 0, 0x7F7F7F7F, 0, 0x7F7F7F7F); \
        else { _Pragma("unroll") for (int k = 0; k < 2; ++k) acc[ai][bj][m][n] = __builtin_amdgcn_mfma_f32_16x16x32_bf16(Bt[n][k], At[m][k], acc[ai][bj][m][n], 0, 0, 0); } } \
        __builtin_amdgcn_s_setprio(0); } while (0)
#define PG8_WAIT_V(n) asm volatile("s_waitcnt vmcnt(" #n ")" ::: "memory")
#define PG8_WAIT_L(n) asm volatile("s_waitcnt lgkmcnt(" #n ")" ::: "memory")
#define PG8_BAR __builtin_amdgcn_s_barrier()
#define PG8_SCHED __builtin_amdgcn_sched_barrier(0)
#define PG8_AOFF(u_, o0, o1) do { _Pragma("unroll") for (int _i = 0; _i < 2; ++_i) { const int r0 = (u_).pm * BM + Rr[_i], r1 = r0 + HALF; \
        const int g0 = GATHER ? g.rowidx[r0] : r0, g1 = GATHER ? g.rowidx[r1] : r1; \
        o0[_i] = (unsigned)g0 * (unsigned)K + (unsigned)Cc[_i]; o1[_i] = (unsigned)g1 * (unsigned)K + (unsigned)Cc[_i]; } } while (0)
    Unit cur, nxt; int ui = 0;
    if (!S.next(0, cur)) return;
    f32x4 acc[2][2][4][2];
#pragma unroll
    for (int a = 0; a < 2; ++a)
#pragma unroll
        for (int b = 0; b < 2; ++b)
#pragma unroll
            for (int m = 0; m < 4; ++m)
#pragma unroll
                for (int n = 0; n < 2; ++n) acc[a][b][m][n] = (f32x4){0.f, 0.f, 0.f, 0.f};
    bf16x8 At[4][2], B0[2][2], B1[2][2];
    unsigned ca0[2], ca1[2];
    PG8_AOFF(cur, ca0, ca1);
    const char* Ab = (const char*)g.A;
    const char* cB = (const char*)g.Bt + (size_t)cur.e * g.b_estride + (size_t)cur.pn * tstep;
    PG8_STAGE(PG8_SB(0, 0), cB, voffB0); PG8_STAGE(PG8_SB(0, 1), cB, voffB1); PG8_STAGE(PG8_SA(0, 0), Ab, ca0); PG8_STAGE(PG8_SA(0, 1), Ab, ca1);
    if (wr == 1) PG8_BAR;
    PG8_WAIT_V(2); PG8_BAR;
    PG8_STAGE(PG8_SB(1, 0), cB + kstep, voffB0); PG8_STAGE(PG8_SA(1, 0), Ab + kstep, ca0); PG8_STAGE(PG8_SB(1, 1), cB + kstep, voffB1);
    PG8_WAIT_V(6); PG8_BAR;
    for (;;) {
        const bool has_next = S.next(ui + 1, nxt);
        const char* nB = has_next ? (const char*)g.Bt + (size_t)nxt.e * g.b_estride + (size_t)nxt.pn * tstep : cB;
#pragma unroll 1
        for (int t = 0; t < nt; t += 2) {
            const bool last = (t == nt - 2);
            const char* a1 = Ab + (size_t)(t + 1) * kstep;
            const char* a2 = last ? Ab : Ab + (size_t)(t + 2) * kstep; const char* b2 = last ? nB : cB + (size_t)(t + 2) * kstep;
            const char* a3 = a2 + kstep; const char* b3 = b2 + kstep;
            PG8_LDB(B0, 0, 0); PG8_LDB(B1, 0, 1); PG8_SCHED; PG8_LDA(At, 0, 0); PG8_STAGE(PG8_SA(1, 1), a1, ca1);
            if (last && has_next) PG8_AOFF(nxt, ca0, ca1);
            PG8_WAIT_V(8); PG8_WAIT_L(0); PG8_BAR; PG8_MMA(0, 0, At, B0); PG8_MMA(0, 1, At, B1); PG8_BAR; PG8_SCHED;
            PG8_LDA(At, 0, 1); PG8_STAGE(PG8_SB(0, 0), b2, voffB0); PG8_STAGE(PG8_SB(0, 1), b2, voffB1); PG8_STAGE(PG8_SA(0, 0), a2, ca0);
            PG8_WAIT_V(8); PG8_WAIT_L(0); PG8_BAR; PG8_MMA(1, 0, At, B0); PG8_MMA(1, 1, At, B1); PG8_BAR; PG8_SCHED;
            PG8_LDB(B0, 1, 0); PG8_LDB(B1, 1, 1); PG8_SCHED; PG8_LDA(At, 1, 0); PG8_STAGE(PG8_SA(0, 1), a2, ca1);
            PG8_WAIT_V(8); PG8_WAIT_L(0); PG8_BAR; PG8_MMA(0, 0, At, B0); PG8_MMA(0, 1, At, B1); PG8_BAR; PG8_SCHED;
            PG8_LDA(At, 1, 1); PG8_STAGE(PG8_SB(1, 0), b3, voffB0); PG8_STAGE(PG8_SB(1, 1), b3, voffB1); PG8_STAGE(PG8_SA(1, 0), a3, ca0);
            PG8_WAIT_V(8); PG8_WAIT_L(0); PG8_BAR; PG8_MMA(1, 0, At, B0); PG8_MMA(1, 1, At, B1); PG8_BAR; PG8_SCHED;
        }
        if constexpr (ALIGN) { if (wr == 0) PG8_BAR; }
        E(acc, cur, wr, wc, fr, fq);
        if (!has_next) break;
#pragma unroll
        for (int a = 0; a < 2; ++a)
#pragma unroll
            for (int b = 0; b < 2; ++b)
#pragma unroll
                for (int m = 0; m < 4; ++m)
#pragma unroll
                    for (int n = 0; n < 2; ++n) acc[a][b][m][n] = (f32x4){0.f, 0.f, 0.f, 0.f};
        cur = nxt; cB = nB; ++ui;
        if constexpr (ALIGN) { if (wr == 1) PG8_BAR; }
    }
    PG8_WAIT_V(0);
    if constexpr (!ALIGN) { if (wr == 0) PG8_BAR; }
    PG8_BAR;
#undef PG8_SA
#undef PG8_SB
#undef PG8_STAGE
#undef PG8_LDA
#undef PG8_LDB
#undef PG8_MMA
#undef PG8_CAT
#undef PG8_WAIT_V
#undef PG8_WAIT_L
#undef PG8_BAR
#undef PG8_SCHED
#undef PG8_AOFF
}

__device__ __forceinline__ unsigned cvt_pk_bf16(float lo, float hi) { typedef __bf16 bf16x2_t __attribute__((ext_vector_type(2))); f32x2 v = {lo, hi}; bf16x2_t b = __builtin_convertvector(v, bf16x2_t); return __builtin_bit_cast(unsigned, b); }

template <bool FP8OUT> struct EpiStore {
    static constexpr bool PERM = true, WIDE = true;
    void* O; int ldc; float scale;
    __device__ __forceinline__ void operator()(const f32x4 (&acc)[2][2][4][2], const Unit& u, int wr, int wc, int fr, int fq) const {
        const int row0 = u.pm * BM + wr * 64 + fr, col0 = u.pn * BM + wc * 64 + 16 * fq;
#pragma unroll
        for (int ai = 0; ai < 2; ++ai)
#pragma unroll
            for (int m = 0; m < 4; ++m) { const size_t off = (size_t)(row0 + ai * HALF + m * 16) * ldc + col0;
                const f32x4 v0 = acc[ai][0][m][0] * scale, v1 = acc[ai][0][m][1] * scale, v2 = acc[ai][1][m][0] * scale, v3 = acc[ai][1][m][1] * scale;
                if constexpr (FP8OUT) { u32x4 w; w.x = pk4_fp8(v0[0], v0[1], v0[2], v0[3]); w.y = pk4_fp8(v1[0], v1[1], v1[2], v1[3]); w.z = pk4_fp8(v2[0], v2[1], v2[2], v2[3]); w.w = pk4_fp8(v3[0], v3[1], v3[2], v3[3]);
                    *(u32x4*)((unsigned char*)O + off) = w; }
                else { u32x4 wa, wb; wa.x = cvt_pk_bf16(v0[0], v0[1]); wa.y = cvt_pk_bf16(v0[2], v0[3]); wa.z = cvt_pk_bf16(v1[0], v1[1]); wa.w = cvt_pk_bf16(v1[2], v1[3]);
                    wb.x = cvt_pk_bf16(v2[0], v2[1]); wb.y = cvt_pk_bf16(v2[2], v2[3]); wb.z = cvt_pk_bf16(v3[0], v3[1]); wb.w = cvt_pk_bf16(v3[2], v3[3]);
                    *(u32x4*)((bf16*)O + off) = wa; *(u32x4*)((bf16*)O + off + 8) = wb; } }
    }
};
typedef EpiStore<false> EpiBf16;
struct EpiResBf16 {
    static constexpr bool PERM = true, WIDE = true;
    bf16* O; const bf16* R; int ldc; float alpha;
    __device__ __forceinline__ void operator()(const f32x4 (&acc)[2][2][4][2], const Unit& u, int wr, int wc, int fr, int fq) const {
        const int row0 = u.pm * BM + wr * 64 + fr, col0 = u.pn * BM + wc * 64 + 16 * fq;
#pragma unroll
        for (int ai = 0; ai < 2; ++ai)
#pragma unroll
            for (int m = 0; m < 4; ++m) { const size_t off = (size_t)(row0 + ai * HALF + m * 16) * ldc + col0;
                const u32x4 ra = *(const u32x4*)(R + off), rb = *(const u32x4*)(R + off + 8);
                const f32x4 v0 = acc[ai][0][m][0], v1 = acc[ai][0][m][1], v2 = acc[ai][1][m][0], v3 = acc[ai][1][m][1];
                u32x4 wa, wb;
                wa.x = cvt_pk_bf16(bflo(ra.x) * alpha + v0[0], bfhi(ra.x) * alpha + v0[1]); wa.y = cvt_pk_bf16(bflo(ra.y) * alpha + v0[2], bfhi(ra.y) * alpha + v0[3]);
                wa.z = cvt_pk_bf16(bflo(ra.z) * alpha + v1[0], bfhi(ra.z) * alpha + v1[1]); wa.w = cvt_pk_bf16(bflo(ra.w) * alpha + v1[2], bfhi(ra.w) * alpha + v1[3]);
                wb.x = cvt_pk_bf16(bflo(rb.x) * alpha + v2[0], bfhi(rb.x) * alpha + v2[1]); wb.y = cvt_pk_bf16(bflo(rb.y) * alpha + v2[2], bfhi(rb.y) * alpha + v2[3]);
                wb.z = cvt_pk_bf16(bflo(rb.z) * alpha + v3[0], bfhi(rb.z) * alpha + v3[1]); wb.w = cvt_pk_bf16(bflo(rb.w) * alpha + v3[2], bfhi(rb.w) * alpha + v3[3]);
                *(u32x4*)(O + off) = wa; *(u32x4*)(O + off + 8) = wb; }
    }
};
struct EpiResF32 {
    static constexpr bool PERM = false, WIDE = false;
    float* C; const float* R; int ldc; float alpha;
    __device__ __forceinline__ void operator()(const f32x4 (&acc)[2][2][4][2], const Unit& u, int wr, int wc, int fr, int fq) const {
        const int row0 = u.pm * BM + wr * 64 + fr, col0 = u.pn * BM + wc * 32 + 4 * fq;
#pragma unroll
        for (int ai = 0; ai < 2; ++ai)
#pragma unroll
            for (int m = 0; m < 4; ++m) { const size_t off = (size_t)(row0 + ai * HALF + m * 16) * ldc + col0;
#pragma unroll
                for (int bj = 0; bj < 2; ++bj)
#pragma unroll
                    for (int n = 0; n < 2; ++n) { const f32x4 r = *(const f32x4*)(R + off + bj * HALF + n * 16); *(f32x4*)(C + off + bj * HALF + n * 16) = r * alpha + acc[ai][bj][m][n]; } }
    }
};
template <bool FP8OUT> struct EpiSwiGlu {
    static constexpr bool PERM = true, WIDE = false;
    void* H; float isc;
    __device__ __forceinline__ void operator()(const f32x4 (&acc)[2][2][4][2], const Unit& u, int wr, int wc, int fr, int fq) const {
        const int row0 = u.pm * BM + wr * 64 + fr, col0 = u.pn * HALF + wc * 32 + 8 * fq;
#pragma unroll
        for (int ai = 0; ai < 2; ++ai)
#pragma unroll
            for (int m = 0; m < 4; ++m) { const size_t off = (size_t)(row0 + ai * HALF + m * 16) * DEXP + col0;
                float hv[8];
#pragma unroll
                for (int n = 0; n < 2; ++n)
#pragma unroll
                    for (int j = 0; j < 4; ++j) { const float gg = acc[ai][0][m][n][j] * isc, uu = acc[ai][1][m][n][j] * isc; hv[4 * n + j] = gg * sigmoidf_(gg) * uu; }
                if constexpr (FP8OUT) { u32x2 w; w.x = pk4_fp8(hv[0], hv[1], hv[2], hv[3]); w.y = pk4_fp8(hv[4], hv[5], hv[6], hv[7]); __builtin_nontemporal_store(w, (u32x2*)((unsigned char*)H + off)); }
                else { u32x4 w; w.x = cvt_pk_bf16(hv[0], hv[1]); w.y = cvt_pk_bf16(hv[2], hv[3]); w.z = cvt_pk_bf16(hv[4], hv[5]); w.w = cvt_pk_bf16(hv[6], hv[7]); __builtin_nontemporal_store(w, (u32x4*)((bf16*)H + off)); } }
    }
};
}

struct TItem { const float* src; bf16* dst; int K, N, k0, n0, drow0; float scale; int fp8; };
constexpr int TI_WIN = (D / 64) * (PW / 64), TI_WOUT = (D / 64) * (D / 64), TI_WGLU = (GW / 64) * (GW / 64), TI_GU1 = (D / 64) * (1024 / 64), TI_DN1 = (DEXP / 64) * (D / 64);
constexpr int TI_LAYER = TI_WIN + TI_WOUT + TI_WGLU + NE1 * TI_GU1 + NE1 * TI_DN1, TI_TOTAL = DEPTH * TI_LAYER;
template <class KA>
__device__ __forceinline__ TItem decode_titem(KA ap, unsigned char* ws, int it) {
    TItem t; const int l = it / TI_LAYER; int r = it % TI_LAYER; t.scale = 1.f; t.fp8 = 0;
    if (r < TI_WIN) { const int nnb = PW / 64; t.K = D; t.N = PW; t.k0 = (r / nnb) * 64; t.n0 = (r % nnb) * 64; t.drow0 = t.n0; t.src = ap->in[1] + (size_t)l * D * PW; t.dst = (bf16*)(ws + WS_WIN) + (size_t)l * PW * D;
        t.scale = (t.n0 >= C_Q && t.n0 < C_K) ? QSCALE : 1.f; return t; }
    r -= TI_WIN;
    if (r < TI_WOUT) { const int nnb = D / 64; t.K = D; t.N = D; t.k0 = (r / nnb) * 64; t.n0 = (r % nnb) * 64; t.drow0 = t.n0; t.src = ap->in[2] + (size_t)l * D * D; t.dst = (bf16*)(ws + WS_WOUT) + (size_t)l * D * D; return t; }
    r -= TI_WOUT;
    if (r < TI_WGLU) { const int nnb = GW / 64; t.K = GW; t.N = GW; t.k0 = (r / nnb) * 64; t.n0 = (r % nnb) * 64; t.drow0 = t.n0; t.src = ap->in[12] + (size_t)l * GW * GW; t.dst = (bf16*)(ws + WS_WGLU) + (size_t)l * GW * GW; return t; }
    r -= TI_WGLU;
    if (r < NE1 * TI_GU1) { const int e = r / TI_GU1, q = r % TI_GU1, nnb = 1024 / 64; t.K = D; t.N = 1024; t.k0 = (q / nnb) * 64; t.n0 = (q % nnb) * 64;
        { const int half = t.n0 / 512, j = t.n0 % 512; t.drow0 = 256 * (j / 128) + 128 * half + (j % 128); }
        t.src = (e < NEXP) ? ap->in[28] + ((size_t)l * NEXP + e) * D * 1024 : ap->in[30] + (size_t)l * D * 1024; t.dst = (bf16*)(ws + WS_WGU) + ((size_t)l * NE1 + e) * 1024 * D;
        if (l >= FP8_FIRST) { t.fp8 = 1; t.scale = W8SCALE; t.dst = (bf16*)(ws + WS_WGU + (size_t)l * NE1 * 1024 * D * 2 + (size_t)e * 1024 * D); }
        return t; }
    r -= NE1 * TI_GU1;
    { const int e = r / TI_DN1, q = r % TI_DN1, nnb = D / 64; t.K = DEXP; t.N = D; t.k0 = (q / nnb) * 64; t.n0 = (q % nnb) * 64; t.drow0 = t.n0;
      t.src = (e < NEXP) ? ap->in[29] + ((size_t)l * NEXP + e) * DEXP * D : ap->in[31] + (size_t)l * DEXP * D; t.dst = (bf16*)(ws + WS_WDN) + ((size_t)l * NE1 + e) * D * DEXP;
      if (DOWN_FP8 && l >= FP8_FIRST) { t.fp8 = 1; t.scale = W8SCALE; t.dst = (bf16*)(ws + WS_WDN + (size_t)l * NE1 * D * DEXP * 2 + (size_t)e * D * DEXP); }
      return t; }
}
__device__ __forceinline__ void titem_load(const TItem& t, f32x4 (&v)[16], int lane) {
    const float* p = t.src + (size_t)(t.k0 + (lane >> 4)) * t.N + t.n0 + (lane & 15) * 4;
#pragma unroll
    for (int i = 0; i < 16; ++i) v[i] = __builtin_nontemporal_load((const f32x4*)(p + (size_t)(4 * i) * t.N));
}
__device__ __forceinline__ void titem_to_lds(const f32x4 (&v)[16], LAS float* scr, int lane) {
    LAS float* q = scr + (lane >> 4) * 65 + (lane & 15) * 4;
#pragma unroll
    for (int i = 0; i < 16; ++i) { q[(4 * i) * 65] = v[i].x; q[(4 * i) * 65 + 1] = v[i].y; q[(4 * i) * 65 + 2] = v[i].z; q[(4 * i) * 65 + 3] = v[i].w; }
}
__device__ __forceinline__ void titem_store(const TItem& t, const LAS float* scr, int lane) {
    if (t.fp8) {
        const int c = lane & 3; const float sc = t.scale; unsigned char* d8 = (unsigned char*)t.dst;
#pragma unroll
        for (int j = 0; j < 4; ++j) { const int n = 16 * j + (lane >> 2); const LAS float* s = scr + (16 * c) * 65 + n;
            u32x4 o; o.x = pk4_fp8(s[0] * sc, s[65] * sc, s[2 * 65] * sc, s[3 * 65] * sc); o.y = pk4_fp8(s[4 * 65] * sc, s[5 * 65] * sc, s[6 * 65] * sc, s[7 * 65] * sc);
            o.z = pk4_fp8(s[8 * 65] * sc, s[9 * 65] * sc, s[10 * 65] * sc, s[11 * 65] * sc); o.w = pk4_fp8(s[12 * 65] * sc, s[13 * 65] * sc, s[14 * 65] * sc, s[15 * 65] * sc);
            *(u32x4*)(d8 + (size_t)(t.drow0 + n) * t.K + t.k0 + 16 * c) = o; }
        return; }
    const int c = lane & 7; const float sc = t.scale;
#pragma unroll
    for (int j = 0; j < 8; ++j) { const int n = 8 * j + (lane >> 3); const LAS float* s = scr + (8 * c) * 65 + n;
        u32x4 o; o.x = pk2(s[0] * sc, s[65] * sc); o.y = pk2(s[2 * 65] * sc, s[3 * 65] * sc); o.z = pk2(s[4 * 65] * sc, s[5 * 65] * sc); o.w = pk2(s[6 * 65] * sc, s[7 * 65] * sc);
        *(u32x4*)(t.dst + (size_t)(t.drow0 + n) * t.K + t.k0 + 8 * c) = o; }
}
constexpr int TI_GTAIL = 8192;
constexpr int TI_DEFER = 8192;
static_assert(TI_DEFER <= NE1 * TI_DN1, "deferred items must be last-layer down weights");
__device__ __forceinline__ void convert_items(const Frame& F, int first, int last, int rank, int nranks) {
    typedef const __attribute__((address_space(4))) Args* KArgs; KArgs ap = (KArgs)__builtin_amdgcn_kernarg_segment_ptr(); asm volatile("" : "+s"(ap));
    unsigned char* ws = ap->ws;
    int lane = lane_id(); asm volatile("" : "+v"(lane));
    LAS float* scr = (LAS float*)(F.lds + F.wave * 16640);
    f32x4 v[16]; int it = first + rank;
    TItem cur = decode_titem(ap, ws, it < last ? it : 0);
    if (it < last) titem_load(cur, v, lane);
    while (it < last) {
        titem_to_lds(v, scr, lane);
        const int nx = it + nranks; const TItem nxt = decode_titem(ap, ws, nx < last ? nx : 0);
        if (nx < last) titem_load(nxt, v, lane);
        asm volatile("s_waitcnt lgkmcnt(0)" ::: "memory");
        titem_store(cur, scr, lane);
        asm volatile("s_waitcnt lgkmcnt(0)" ::: "memory");
        cur = nxt; it = nx;
    }
}
__device__ __forceinline__ void p0_prologue(const Frame& F, const Args& a_) {
    typedef const __attribute__((address_space(4))) Args* KArgs; KArgs ap = (KArgs)__builtin_amdgcn_kernarg_segment_ptr(); asm volatile("" : "+s"(ap));
#define a (*ap)
    unsigned char* ws = a.ws;
    int lane = lane_id(); asm volatile("" : "+v"(lane));
    LAS float* scr = (LAS float*)(F.lds + F.wave * 16640);
    const int gw = F.vcu * NWAVES + F.wave, NGW = F.G * NWAVES;
    const int gt = gw * 64 + lane, NGT = NGW * 64;
    { const f32x4* x4 = (const f32x4*)a.in[0]; u32x2* o = (u32x2*)(ws + WS_XB);
      for (size_t i = gt; i < (size_t)T * D / 4; i += NGT) { const f32x4 v = x4[i]; u32x2 w; w.x = pk2(v.x, v.y); w.y = pk2(v.z, v.w); o[i] = w; } }
    for (int l = 0; l < DEPTH; ++l) {
        {
            unsigned char* tab = ws + WS_S5TAB + (size_t)l * S5TAB_STRIDE;
            const float* lre = a.in[4] + l * 2048; const float* lim = a.in[5] + l * 2048; const float* ldt = a.in[6] + l * 32;
            const float* bre = a.in[7] + (size_t)l * 32768; const float* bim = a.in[8] + (size_t)l * 32768;
            const float* cre = a.in[9] + (size_t)l * 32768; const float* cim = a.in[10] + (size_t)l * 32768;
            for (int i = gt; i < 2048; i += NGT) {
                const int g = i >> 6; const float dt = expf(ldt[g]); const float ar = lre[i], ai = lim[i];
                const float er = expf(ar * dt); const float sn = sinf(ai * dt), cs = cosf(ai * dt);
                const float abr = er * cs, abi = er * sn;
                ((f32x2*)(tab + S5T_ABAR))[i] = (f32x2){abr, abi};
                const float eL = expf(ar * dt * 64.0f); const float snL = sinf(ai * dt * 64.0f), csL = cosf(ai * dt * 64.0f);
                ((f32x2*)(tab + S5T_AL))[i] = (f32x2){eL * csL, eL * snL};
                const float nr = abr - 1.0f, ni = abi, den = ar * ar + ai * ai;
                const float cr = (nr * ar + ni * ai) / den, ci = (ni * ar - nr * ai) / den;
                bf16* bm = (bf16*)(tab + S5T_BMAT) + (size_t)g * 128 * 16; const int p = i & 63;
#pragma unroll 4
                for (int h = 0; h < 16; ++h) { const float br = bre[(size_t)i * 16 + h], bi = bim[(size_t)i * 16 + h];
                    bm[p * 16 + h] = (bf16)f2bf(cr * br - ci * bi); bm[(64 + p) * 16 + h] = (bf16)f2bf(cr * bi + ci * br); }
            }
            const float* dd = a.in[11] + l * GW;
            for (int i = gt; i < 32 * 32 * CM_PITCH; i += NGT) {
                const int g = i / (32 * CM_PITCH), hh = (i / CM_PITCH) & 31, k = i % CM_PITCH; float v = 0.f;
                if (hh < 16) { if (k < 64) v = cre[((size_t)g * 16 + hh) * 64 + k]; else if (k < 128) v = -cim[((size_t)g * 16 + hh) * 64 + (k - 64)]; else v = (k - 128 == hh) ? dd[16 * g + hh] : 0.f; }
                ((bf16*)(tab + S5T_CMAT))[i] = (bf16)f2bf(v);
            }
        }
        { const float* sw = a.in[16] + (size_t)l * 65536; bf16* o = (bf16*)(ws + WS_SGUW) + (size_t)l * 65536;
          for (int i = gt; i < 65536; i += NGT) o[i] = (bf16)f2bf(sw[i]); }
        {
            const float* rw = a.in[26] + (size_t)l * D * NEXP; bf16* hi = (bf16*)(ws + WS_RT) + (size_t)l * 2 * NEXP * D; bf16* lo = hi + (size_t)NEXP * D;
            for (int i = gt; i < NEXP * D; i += NGT) { const int e = i / D, k = i % D; const float v = rw[(size_t)k * NEXP + e]; const unsigned h = f2bf(v); hi[i] = (bf16)h; lo[i] = (bf16)f2bf(v - bf2f(h)); }
        }
    }
    if (F.G == 256) convert_items(F, 0, TI_WIN, gw, NGW); else convert_items(F, 0, TI_TOTAL - TI_DEFER, gw, NGW);
#undef a
}

namespace at {
constexpr int STAGE = 32768, LDS_LUT = 2 * STAGE, LDS_ATT_BYTES = LDS_LUT + 1024;
__device__ __forceinline__ int t5_bucket(int rel) {
    const int ret = rel > 0 ? 16 : 0; const int n = rel < 0 ? -rel : rel;
    int b;
    if (n < 8) b = n; else if (n < 12) b = 8; else if (n < 16) b = 9; else if (n < 23) b = 10; else if (n < 32) b = 11; else if (n < 46) b = 12; else if (n < 64) b = 13; else if (n < 91) b = 14; else b = 15;
    return ret + b;
}
__device__ __forceinline__ s16x4 vtr(const LAS unsigned char* p) { typedef short v4i16_t __attribute__((ext_vector_type(4))); return __builtin_bit_cast(s16x4, __builtin_amdgcn_ds_read_tr16_b64_v4i16((LAS v4i16_t*)p)); }

__device__ __forceinline__ void attn_unit(const Frame& F, const bf16* __restrict__ proj, bf16* mix, const float* relb, const float* subg, int h, int qb, float lam, float one_m_li) {
    LAS unsigned char* lds = F.lds;
    int tid = F.wave * 64 + lane_id(); asm volatile("" : "+v"(tid));
    const int lane = tid & 63, w = F.wave, r32 = lane & 31, hi = lane >> 5, m = w >> 2, wq = w & 3;
    const int q0 = qb * 128, qrow = q0 + 32 * wq + r32, cw = (q0 + 32 * wq) >> 6, NT = 2 * qb + 2;
    LAS float* lut = (LAS float*)(lds + LDS_LUT);
    if (tid < 256) { const int rel = tid - 192; lut[tid] = (relb[t5_bucket(rel) * 4 + h] - relb[15 * 4 + h]) * LOG2E; }
    bf16x8 qr[4];
#pragma unroll
    for (int d0 = 0; d0 < 4; ++d0) qr[d0] = *(const bf16x8*)(proj + (size_t)qrow * PW + C_Q + h * 128 + m * 64 + 16 * d0 + 8 * hi);
    u32x4 rk[2], rv[2];
    const bf16* kbase = proj + C_K + h * 128; const bf16* vbase = proj + C_V + h * 128;
#define AT_LOAD(j) do { _Pragma("unroll") for (int i = 0; i < 2; ++i) { const int id = tid + 512 * i, row = id >> 4, c16 = id & 15; \
        rk[i] = *(const u32x4*)(kbase + (size_t)(64 * (j) + row) * PW + c16 * 8); rv[i] = *(const u32x4*)(vbase + (size_t)(64 * (j) + row) * PW + c16 * 8); } } while (0)
#define AT_STORE(buf) do { _Pragma("unroll") for (int i = 0; i < 2; ++i) { const int id = tid + 512 * i, row = id >> 4, c16 = id & 15, mk = c16 >> 3, c = c16 & 7; \
        *(LAS u32x4*)(lds + (buf) * STAGE + mk * 8192 + c * 1024 + ((row ^ c) * 16)) = rk[i]; \
        *(LAS u32x4*)(lds + (buf) * STAGE + 16384 + (c16 >> 2) * 4096 + row * 64 + (c16 & 3) * 16) = rv[i]; } } while (0)
    AT_LOAD(0);
    __syncthreads();
    AT_STORE(0);
    AT_LOAD(1);
    __syncthreads();
    float mrun = 0.f, lsum = 0.f;
    f32x16 negm = (f32x16){};
    f32x16 o[4];
#pragma unroll
    for (int eb = 0; eb < 4; ++eb) o[eb] = (f32x16){};
    for (int j = 0; j < NT; ++j) {
        const int cur = j & 1;
        bf16x8 kf[2][2];
        const LAS unsigned char* Kb = lds + cur * STAGE + m * 8192;
        if (j <= cw) {
#pragma unroll
            for (int d0 = 0; d0 < 2; ++d0) { const int c = 2 * d0 + hi; kf[d0][0] = *(const LAS bf16x8*)(Kb + c * 1024 + ((r32 ^ c) * 16)); kf[d0][1] = *(const LAS bf16x8*)(Kb + c * 1024 + ((r32 ^ c) * 16) + 512); } }
        __builtin_amdgcn_sched_barrier(0);
        if (j + 1 < NT) AT_STORE(cur ^ 1);
        if (j + 2 < NT) AT_LOAD(j + 2);
        if (j <= cw) {
            f32x16 p0, p1;
#pragma unroll
            for (int d0 = 0; d0 < 4; ++d0) { const int c = 2 * d0 + hi;
                const bf16x8 a0 = (d0 < 2) ? kf[d0 & 1][0] : *(const LAS bf16x8*)(Kb + c * 1024 + ((r32 ^ c) * 16));
                const bf16x8 a1 = (d0 < 2) ? kf[d0 & 1][1] : *(const LAS bf16x8*)(Kb + c * 1024 + ((r32 ^ c) * 16) + 512);
                if (d0 == 0) { p0 = __builtin_amdgcn_mfma_f32_32x32x16_bf16(a0, qr[0], negm, 0, 0, 0); p1 = __builtin_amdgcn_mfma_f32_32x32x16_bf16(a1, qr[0], negm, 0, 0, 0); }
                else { p0 = __builtin_amdgcn_mfma_f32_32x32x16_bf16(a0, qr[d0], p0, 0, 0, 0); p1 = __builtin_amdgcn_mfma_f32_32x32x16_bf16(a1, qr[d0], p1, 0, 0, 0); } }
            if (j >= cw - 2) {
                const int base = 64 * j - qrow + 192;
#pragma unroll
                for (int r = 0; r < 16; ++r) { const int kv = crow(r, hi); p0[r] += lut[base + kv]; p1[r] += lut[base + kv + 32]; }
            }
            float mx = fmaxf(fmaxf(p0[0], p0[1]), p1[0]), mb = fmaxf(fmaxf(p0[2], p0[3]), p1[1]); mx = fmaxf(fmaxf(mx, p1[2]), p1[3]);
#pragma unroll
            for (int r = 4; r < 16; r += 4) { mx = fmaxf(fmaxf(mx, p0[r]), p0[r + 1]); mb = fmaxf(fmaxf(mb, p0[r + 2]), p0[r + 3]); mx = fmaxf(fmaxf(mx, p1[r]), p1[r + 1]); mb = fmaxf(fmaxf(mb, p1[r + 2]), p1[r + 3]); }
            mx = swap_max(fmaxf(mx, mb));
            if (j == 0 || __any(mx > 8.0f)) {
                const float dl = (j == 0) ? mx : fmaxf(mx, 0.f); mrun += dl;
                const float alpha = __builtin_amdgcn_exp2f(-dl); lsum *= alpha;
#pragma unroll
                for (int r = 0; r < 16; ++r) { p0[r] -= dl; p1[r] -= dl; negm[r] = -mrun; }
#pragma unroll
                for (int eb = 0; eb < 4; ++eb)
#pragma unroll
                    for (int r = 0; r < 16; ++r) o[eb][r] *= alpha;
            }
            bf16x8 pb[4]; float lpart[4];
#define AT_EXPBLK(s_) do { float sm_ = 0.f; u32x4 wv_; \
            if ((s_) < 2) { _Pragma("unroll") for (int i_ = 0; i_ < 8; ++i_) { p0[8 * (s_) + i_] = __builtin_amdgcn_exp2f(p0[8 * (s_) + i_]); } \
                sm_ = ((p0[8 * (s_) + 0] + p0[8 * (s_) + 1]) + (p0[8 * (s_) + 2] + p0[8 * (s_) + 3])) + ((p0[8 * (s_) + 4] + p0[8 * (s_) + 5]) + (p0[8 * (s_) + 6] + p0[8 * (s_) + 7])); \
                wv_.x = gm::cvt_pk_bf16(p0[8 * (s_) + 0], p0[8 * (s_) + 1]); wv_.y = gm::cvt_pk_bf16(p0[8 * (s_) + 2], p0[8 * (s_) + 3]); wv_.z = gm::cvt_pk_bf16(p0[8 * (s_) + 4], p0[8 * (s_) + 5]); wv_.w = gm::cvt_pk_bf16(p0[8 * (s_) + 6], p0[8 * (s_) + 7]); } \
            else { constexpr int b_ = 8 * ((s_) & 1); _Pragma("unroll") for (int i_ = 0; i_ < 8; ++i_) { p1[b_ + i_] = __builtin_amdgcn_exp2f(p1[b_ + i_]); } \
                sm_ = ((p1[b_ + 0] + p1[b_ + 1]) + (p1[b_ + 2] + p1[b_ + 3])) + ((p1[b_ + 4] + p1[b_ + 5]) + (p1[b_ + 6] + p1[b_ + 7])); \
                wv_.x = gm::cvt_pk_bf16(p1[b_ + 0], p1[b_ + 1]); wv_.y = gm::cvt_pk_bf16(p1[b_ + 2], p1[b_ + 3]); wv_.z = gm::cvt_pk_bf16(p1[b_ + 4], p1[b_ + 5]); wv_.w = gm::cvt_pk_bf16(p1[b_ + 6], p1[b_ + 7]); } \
            lpart[s_] = sm_; pb[s_] = __builtin_bit_cast(bf16x8, wv_); } while (0)
            AT_EXPBLK(0);
            const unsigned vaddr = (unsigned)(uintptr_t)(lds + cur * STAGE + 16384 + (4 * hi + ((lane & 15) >> 2)) * 64 + ((lane >> 4) & 1) * 32 + (lane & 3) * 8);
            s16x4 fl[2][4], fh[2][4];
#define AT_TRR(dst, off) asm volatile("ds_read_b64_tr_b16 %0, %1 offset:%c2" : "=&v"(dst) : "v"(vaddr), "i"(off) : "memory")
#pragma unroll
            for (int eb = 0; eb < 4; ++eb) { AT_TRR(fl[0][eb], eb * 4096); AT_TRR(fh[0][eb], eb * 4096 + 512); }
#define AT_PVSTEP(s_) do { \
                if ((s_) < 3) { _Pragma("unroll") for (int eb = 0; eb < 4; ++eb) { AT_TRR(fl[((s_) + 1) & 1][eb], eb * 4096 + ((s_) + 1) * 1024); AT_TRR(fh[((s_) + 1) & 1][eb], eb * 4096 + ((s_) + 1) * 1024 + 512); } \
                    asm volatile("s_waitcnt lgkmcnt(8)" ::: "memory"); } else asm volatile("s_waitcnt lgkmcnt(0)" ::: "memory"); \
                __builtin_amdgcn_sched_barrier(0); \
                _Pragma("unroll") for (int eb = 0; eb < 4; ++eb) { const s16x4 lo = fl[(s_) & 1][eb], hh = fh[(s_) & 1][eb]; \
                    const bf16x8 vf = (bf16x8){lo[0], lo[1], lo[2], lo[3], hh[0], hh[1], hh[2], hh[3]}; \
                    o[eb] = __builtin_amdgcn_mfma_f32_32x32x16_bf16(vf, pb[s_], o[eb], 0, 0, 0); } } while (0)
#define AT_PIN() do { _Pragma("unroll") for (int g_ = 0; g_ < 4; ++g_) { __builtin_amdgcn_sched_group_barrier(0x008, 1, 0); __builtin_amdgcn_sched_group_barrier(0x400, 2, 0); __builtin_amdgcn_sched_group_barrier(0x002, 2, 0); } \
                __builtin_amdgcn_sched_barrier(0); } while (0)
            AT_PVSTEP(0); AT_EXPBLK(1); AT_PIN();
            AT_PVSTEP(1); AT_EXPBLK(2); AT_PIN();
            AT_PVSTEP(2); AT_EXPBLK(3); AT_PIN();
            AT_PVSTEP(3); __builtin_amdgcn_sched_barrier(0);
            lsum += (lpart[0] + lpart[1]) + (lpart[2] + lpart[3]);
#undef AT_EXPBLK
#undef AT_PVSTEP
#undef AT_PIN
#undef AT_TRR
        }
        __syncthreads();
    }
#undef AT_LOAD
#undef AT_STORE
    { const float lt = swap_sum(lsum); const float inv = 1.0f / lt;
#pragma unroll
      for (int eb = 0; eb < 4; ++eb)
#pragma unroll
          for (int r = 0; r < 16; ++r) o[eb][r] *= inv; }
    LAS float* xch = (LAS float*)lds;
    if (m == 1) {
#pragma unroll
        for (int eb = 0; eb < 4; ++eb)
#pragma unroll
            for (int r = 0; r < 16; ++r) xch[(wq * 64 + eb * 16 + r) * 64 + lane] = o[eb][r];
    }
    __syncthreads();
    if (m == 0) {
        float ss = 0.f;
#pragma unroll
        for (int eb = 0; eb < 4; ++eb)
#pragma unroll
            for (int r = 0; r < 16; ++r) { const float v = o[eb][r] - lam * xch[(wq * 64 + eb * 16 + r) * 64 + lane]; o[eb][r] = v; ss += v * v; }
        ss = swap_sum(ss);
        const float rstd = rsqrtf(ss * (1.0f / 128.0f) + EPS) * one_m_li;
        bf16* orow = mix + (size_t)qrow * D + 1536 + h * 128;
#pragma unroll
        for (int eb = 0; eb < 4; ++eb)
#pragma unroll
            for (int rq = 0; rq < 4; ++rq) { const int e0 = 32 * eb + 8 * rq + 4 * hi;
                const f32x4 gq = *(const f32x4*)(subg + e0);
                u32x2 wv; wv.x = gm::cvt_pk_bf16(o[eb][4 * rq + 0] * rstd * gq.x, o[eb][4 * rq + 1] * rstd * gq.y); wv.y = gm::cvt_pk_bf16(o[eb][4 * rq + 2] * rstd * gq.z, o[eb][4 * rq + 3] * rstd * gq.w);
                *(u32x2*)(orow + e0) = wv; }
    }
    __syncthreads();
}
}

namespace s5 {
constexpr int SB_PITCH = 136, YG_PITCH = 520, SB_BYTES = 32 * SB_PITCH * 2;
constexpr int LDS_YG = 0, LDS_SB = 64 * YG_PITCH * 2, LDS_RED = LDS_SB + 8 * SB_BYTES, LDS_S5_BYTES = LDS_RED + 8 * 64 * 4;
static_assert(LDS_S5_BYTES <= LDS_MISC, "s5 lds");

__device__ __forceinline__ void scan16(f32x16& re, f32x16& im, float ar, float ai, float& cr, float& ci, int hi) {
    float sr = hi ? 0.f : cr, si = hi ? 0.f : ci;
#pragma unroll
    for (int r = 0; r < 16; ++r) { const float nr = ar * sr - ai * si + re[r], ni = ar * si + ai * sr + im[r]; sr = nr; si = ni; re[r] = sr; im[r] = si; }
    float xr = partner32(sr, hi), xi = partner32(si, hi);
    xr = hi ? xr : 0.f; xi = hi ? xi : 0.f;
    float pr = ar, pi = ai; asm volatile("" : "+v"(pr), "+v"(pi));
#pragma unroll
    for (int r = 0; r < 16; ++r) { re[r] += pr * xr - pi * xi; im[r] += pr * xi + pi * xr; const float t = pr * ar - pi * ai; pi = pr * ai + pi * ar; pr = t; }
    const float er = partner32(re[15], hi), ei = partner32(im[15], hi);
    cr = hi ? re[15] : er; ci = hi ? im[15] : ei;
}

template <bool FINAL>
__device__ __forceinline__ void s5_group(int lane, const unsigned char* tab, const bf16* __restrict__ proj, f32x2* E, int c, int g, LAS bf16* sbuf, LAS bf16* yg) {
    const int r32 = lane & 31, hi = lane >> 5;
    const f32x2* abar = (const f32x2*)(tab + S5T_ABAR);
    const bf16* bmat = (const bf16*)(tab + S5T_BMAT) + (size_t)g * 128 * 16; const bf16* cmat = (const bf16*)(tab + S5T_CMAT) + (size_t)g * 32 * CM_PITCH;
    const f32x2 a0 = abar[g * 64 + r32], a1 = abar[g * 64 + 32 + r32];
    bf16x8 bfr[4];
#pragma unroll
    for (int pt = 0; pt < 4; ++pt) bfr[pt] = *(const bf16x8*)(bmat + (32 * pt + r32) * 16 + 8 * hi);
    float c0r = 0.f, c0i = 0.f, c1r = 0.f, c1i = 0.f;
    if (FINAL) { const f32x2 v0 = E[((size_t)c * 32 + g) * 64 + r32], v1 = E[((size_t)c * 32 + g) * 64 + 32 + r32]; c0r = v0.x; c0i = v0.y; c1r = v1.x; c1i = v1.y; }
    const int tok0 = 64 * c + 16 * ((r32 >> 2) & 1) + 4 * (r32 >> 3) + (r32 & 3);
    const bf16x8 ufr0 = *(const bf16x8*)(proj + (size_t)tok0 * PW + C_S5U + 16 * g + 8 * hi), ufr1 = *(const bf16x8*)(proj + (size_t)(tok0 + 32) * PW + C_S5U + 16 * g + 8 * hi);
    bf16x8 dfr0 = ufr0, dfr1 = ufr1;
    if (FINAL) { dfr0 = *(const bf16x8*)(proj + (size_t)(64 * c + r32) * PW + C_S5U + 16 * g + 8 * hi); dfr1 = *(const bf16x8*)(proj + (size_t)(64 * c + 32 + r32) * PW + C_S5U + 16 * g + 8 * hi); }
#pragma unroll 1
    for (int tt = 0; tt < 2; ++tt) {
        const int t0 = 64 * c + 32 * tt;
        const bf16x8 ufr = tt ? ufr1 : ufr0;
        f32x16 acc[4];
#pragma unroll
        for (int pt = 0; pt < 4; ++pt) acc[pt] = __builtin_amdgcn_mfma_f32_32x32x16_bf16(ufr, bfr[pt], (f32x16){}, 0, 0, 0);
        scan16(acc[0], acc[2], a0.x, a0.y, c0r, c0i, hi);
        scan16(acc[1], acc[3], a1.x, a1.y, c1r, c1i, hi);
        if (FINAL) {
            LAS bf16* sw = sbuf + (16 * hi) * SB_PITCH + r32;
#pragma unroll
            for (int pt = 0; pt < 4; ++pt)
#pragma unroll
                for (int r = 0; r < 16; ++r) sw[r * SB_PITCH + 32 * pt] = (bf16)f2bf(acc[pt][r]);
            asm volatile("s_waitcnt lgkmcnt(0)" ::: "memory");
            f32x16 y = (f32x16){};
            const LAS bf16* sr = sbuf + r32 * SB_PITCH + 8 * hi; const bf16* cr_ = cmat + r32 * CM_PITCH + 8 * hi;
#pragma unroll
            for (int ks = 0; ks < 8; ++ks) { const bf16x8 afr = *(const LAS bf16x8*)(sr + 16 * ks); const bf16x8 cfr = *(const bf16x8*)(cr_ + 16 * ks);
                y = __builtin_amdgcn_mfma_f32_32x32x16_bf16(afr, cfr, y, 0, 0, 0); }
            { const bf16x8 afr = tt ? dfr1 : dfr0; const bf16x8 cfr = *(const bf16x8*)(cr_ + 128);
              y = __builtin_amdgcn_mfma_f32_32x32x16_bf16(afr, cfr, y, 0, 0, 0); }
            if (r32 < 16) { LAS bf16* yw = yg + (32 * tt + 4 * hi) * YG_PITCH + 16 * g + r32;
#pragma unroll
                for (int r = 0; r < 16; ++r) yw[((r & 3) + 8 * (r >> 2)) * YG_PITCH] = (bf16)f2bf(gelu_tanh(y[r])); }
            asm volatile("s_waitcnt lgkmcnt(0)" ::: "memory");
        }
    }
    if (!FINAL) { E[((size_t)c * 32 + g) * 64 + r32 + 32 * hi] = hi ? (f32x2){c1r, c1i} : (f32x2){c0r, c0i}; }
}

__device__ __forceinline__ void s5_carry_scan(const unsigned char* tab, const f32x2* E, f32x2* Sin, int g, int lane) {
    const f32x2 al = ((const f32x2*)(tab + S5T_AL))[g * 64 + lane];
    const f32x2* e0 = E + (size_t)g * 64 + lane; f32x2* s0 = Sin + (size_t)g * 64 + lane;
    float sr = 0.f, si = 0.f;
#pragma unroll 1
    for (int cb = 0; cb < 256; cb += 16) {
        f32x2 v[16];
#pragma unroll
        for (int i = 0; i < 16; ++i) v[i] = e0[(size_t)(cb + i) * 2048];
#pragma unroll
        for (int i = 0; i < 16; ++i) { s0[(size_t)(cb + i) * 2048] = (f32x2){sr, si}; const float t = al.x * sr - al.y * si + v[i].x; si = al.x * si + al.y * sr + v[i].y; sr = t; }
    }
}

__device__ __forceinline__ void s5_carry_scan_par(const unsigned char* tab, const f32x2* E, f32x2* Sin, int g, int lane, int w, LAS unsigned char* lds) {
    const f32x2 al = ((const f32x2*)(tab + S5T_AL))[g * 64 + lane];
    const f32x2* e0 = E + ((size_t)(32 * w) * 32 + g) * 64 + lane; f32x2* s0 = Sin + ((size_t)(32 * w) * 32 + g) * 64 + lane;
    f32x2 v[32];
#pragma unroll
    for (int i = 0; i < 32; ++i) v[i] = e0[(size_t)i * 2048];
    float sr = 0.f, si = 0.f;
#pragma unroll
    for (int i = 0; i < 32; ++i) { const float er = v[i].x, ei = v[i].y; v[i] = (f32x2){sr, si}; const float t = al.x * sr - al.y * si + er; si = al.x * si + al.y * sr + ei; sr = t; }
    LAS f32x2* tot = (LAS f32x2*)lds;
    tot[w * 64 + lane] = (f32x2){sr, si};
    float pr = al.x, pi = al.y;
#pragma unroll
    for (int k = 0; k < 5; ++k) { const float t = pr * pr - pi * pi; pi = 2.0f * pr * pi; pr = t; }
    __syncthreads();
    float cr = 0.f, ci = 0.f;
    for (int k = 0; k < w; ++k) { const f32x2 tk = tot[k * 64 + lane]; const float t = pr * cr - pi * ci + tk.x; ci = pr * ci + pi * cr + tk.y; cr = t; }
    float qr = 1.f, qi = 0.f;
#pragma unroll
    for (int i = 0; i < 32; ++i) { s0[(size_t)i * 2048] = (f32x2){v[i].x + qr * cr - qi * ci, v[i].y + qr * ci + qi * cr}; const float t = qr * al.x - qi * al.y; qi = qr * al.y + qi * al.x; qr = t; }
}

__device__ __forceinline__ void s5_final_chunk(const Frame& F, const unsigned char* tab, const bf16* __restrict__ proj, f32x2* E, const bf16* __restrict__ wglu_t, const float* mixg, bf16* mix, int c) {
    int lane = lane_id(); asm volatile("" : "+v"(lane));
    const int w = F.wave, r32 = lane & 31, hi = lane >> 5;
    LAS bf16* yg = (LAS bf16*)(F.lds + LDS_YG); LAS bf16* sbuf = (LAS bf16*)(F.lds + LDS_SB + w * SB_BYTES); LAS float* red = (LAS float*)(F.lds + LDS_RED);
#pragma unroll 1
    for (int gi = 0; gi < 4; ++gi) s5_group<true>(lane, tab, proj, E, c, 4 * w + gi, sbuf, yg);
    __syncthreads();
    f32x16 z[2][2];
#pragma unroll
    for (int a = 0; a < 2; ++a)
#pragma unroll
        for (int b = 0; b < 2; ++b) z[a][b] = (f32x16){};
    const int n0 = 64 * w;
    const bf16* wr_ = wglu_t + (size_t)(n0 + r32) * GW + 8 * hi; const LAS bf16* yr_ = yg + r32 * YG_PITCH + 8 * hi;
#pragma unroll 8
    for (int ks = 0; ks < 32; ++ks) {
        bf16x8 afr[2], bfr[2];
#pragma unroll
        for (int nt = 0; nt < 2; ++nt) afr[nt] = *(const bf16x8*)(wr_ + (size_t)(32 * nt) * GW + 16 * ks);
#pragma unroll
        for (int tt = 0; tt < 2; ++tt) bfr[tt] = *(const LAS bf16x8*)(yr_ + (32 * tt) * YG_PITCH + 16 * ks);
#pragma unroll
        for (int nt = 0; nt < 2; ++nt)
#pragma unroll
            for (int tt = 0; tt < 2; ++tt) z[nt][tt] = __builtin_amdgcn_mfma_f32_32x32x16_bf16(afr[nt], bfr[tt], z[nt][tt], 0, 0, 0);
    }
#pragma unroll
    for (int tt = 0; tt < 2; ++tt) { const int t = 32 * tt + r32; float ss = 0.f;
#pragma unroll
        for (int nt = 0; nt < 2; ++nt)
#pragma unroll
            for (int rq = 0; rq < 4; ++rq) { const int n4 = n0 + 32 * nt + 8 * rq + 4 * hi; const u32x2 yv = *(const LAS u32x2*)(yg + t * YG_PITCH + n4);
                const float y0 = bflo(yv.x), y1 = bfhi(yv.x), y2 = bflo(yv.y), y3 = bfhi(yv.y);
                float v;
                v = y0 * sigmoidf_(z[nt][tt][4 * rq + 0]); z[nt][tt][4 * rq + 0] = v; ss += v * v;
                v = y1 * sigmoidf_(z[nt][tt][4 * rq + 1]); z[nt][tt][4 * rq + 1] = v; ss += v * v;
                v = y2 * sigmoidf_(z[nt][tt][4 * rq + 2]); z[nt][tt][4 * rq + 2] = v; ss += v * v;
                v = y3 * sigmoidf_(z[nt][tt][4 * rq + 3]); z[nt][tt][4 * rq + 3] = v; ss += v * v; }
        ss = swap_sum(ss);
        if (hi == 0) red[w * 64 + t] = ss; }
    __syncthreads();
#pragma unroll
    for (int tt = 0; tt < 2; ++tt) { const int t = 32 * tt + r32; float tot = 0.f;
#pragma unroll
        for (int ww = 0; ww < 8; ++ww) tot += red[ww * 64 + t];
        const float rstd = rsqrtf(tot * (1.0f / 512.0f) + EPS);
        bf16* orow = mix + (size_t)(64 * c + t) * D;
#pragma unroll
        for (int nt = 0; nt < 2; ++nt)
#pragma unroll
            for (int rq = 0; rq < 4; ++rq) { const int n4 = n0 + 32 * nt + 8 * rq + 4 * hi; const f32x4 gq = *(const f32x4*)(mixg + n4);
                u32x2 wv; wv.x = gm::cvt_pk_bf16(z[nt][tt][4 * rq + 0] * rstd * gq.x, z[nt][tt][4 * rq + 1] * rstd * gq.y); wv.y = gm::cvt_pk_bf16(z[nt][tt][4 * rq + 2] * rstd * gq.z, z[nt][tt][4 * rq + 3] * rstd * gq.w);
                *(u32x2*)(orow + n4) = wv; } }
    __syncthreads();
}
}

__device__ __forceinline__ void conv_row(const Frame& F, const bf16* __restrict__ proj, const float* cw, const float* mixg, bf16* mix, int t) {
    int lane = lane_id(); asm volatile("" : "+v"(lane));
    const int c0 = 8 * lane;
    float z[3][8];
#pragma unroll
    for (int k = 0; k < 3; ++k) { const int tt = t - 2 + k;
        if (tt >= 0) { const u32x4 a = *(const u32x4*)(proj + (size_t)tt * PW + C_CC + c0), b = *(const u32x4*)(proj + (size_t)tt * PW + C_CH + c0);
            z[k][0] = bflo(a.x) * bflo(b.x); z[k][1] = bfhi(a.x) * bfhi(b.x); z[k][2] = bflo(a.y) * bflo(b.y); z[k][3] = bfhi(a.y) * bfhi(b.y);
            z[k][4] = bflo(a.z) * bflo(b.z); z[k][5] = bfhi(a.z) * bfhi(b.z); z[k][6] = bflo(a.w) * bflo(b.w); z[k][7] = bfhi(a.w) * bfhi(b.w); }
        else {
#pragma unroll
            for (int j = 0; j < 8; ++j) z[k][j] = 0.f; } }
    const u32x4 bb = *(const u32x4*)(proj + (size_t)t * PW + C_CB + c0);
    const float bv[8] = {bflo(bb.x), bfhi(bb.x), bflo(bb.y), bfhi(bb.y), bflo(bb.z), bfhi(bb.z), bflo(bb.w), bfhi(bb.w)};
    float o[8]; float ss = 0.f;
#pragma unroll
    for (int j = 0; j < 8; ++j) { const float cv = cw[c0 + j] * z[0][j] + cw[GW + c0 + j] * z[1][j] + cw[2 * GW + c0 + j] * z[2][j]; o[j] = bv[j] * cv; ss += o[j] * o[j]; }
    ss = wave_sum(ss);
    const float rstd = rsqrtf(ss * (1.0f / 512.0f) + EPS);
    u32x4 wv; wv.x = pk2(o[0] * rstd * mixg[c0], o[1] * rstd * mixg[c0 + 1]); wv.y = pk2(o[2] * rstd * mixg[c0 + 2], o[3] * rstd * mixg[c0 + 3]);
    wv.z = pk2(o[4] * rstd * mixg[c0 + 4], o[5] * rstd * mixg[c0 + 5]); wv.w = pk2(o[6] * rstd * mixg[c0 + 6], o[7] * rstd * mixg[c0 + 7]);
    *(u32x4*)(mix + (size_t)t * D + 512 + c0) = wv;
}

namespace sgu {
constexpr int LDS_V = 0, LDS_RED = 131072, LDS_SGU_BYTES = LDS_RED + 4 * 128 * 4;
static_assert(LDS_SGU_BYTES <= LDS_MISC, "sgu lds");
__device__ __forceinline__ void sgu_block(const Frame& F, const bf16* __restrict__ proj, const float* lng, const float* lnb, const bf16* __restrict__ wsb, const float* sb, const float* mixg, bf16* mix, int blk) {
    int lane = lane_id(); asm volatile("" : "+v"(lane));
    LAS unsigned char* lds = F.lds; LAS float* red = (LAS float*)(lds + LDS_RED);
    const int w = F.wave, r32 = lane & 31, hi = lane >> 5, t0 = 128 * blk;
    u32x4 araw[16];
#pragma unroll
    for (int jj = 0; jj < 16; ++jj) araw[jj] = *(const u32x4*)(proj + (size_t)(t0 + w + 8 * jj) * PW + C_SV + 8 * lane);
#pragma unroll
    for (int jj = 0; jj < 16; ++jj) { const int j = w + 8 * jj;
        const int c0 = 8 * lane; const u32x4 a = araw[jj];
        float v[8] = {bflo(a.x), bfhi(a.x), bflo(a.y), bfhi(a.y), bflo(a.z), bfhi(a.z), bflo(a.w), bfhi(a.w)};
        float s = 0.f;
#pragma unroll
        for (int q = 0; q < 8; ++q) { v[q] = gelu_tanh(v[q]); s += v[q]; }
        const float mean = wave_sum(s) * (1.0f / 512.0f); float s2 = 0.f;
#pragma unroll
        for (int q = 0; q < 8; ++q) { v[q] -= mean; s2 += v[q] * v[q]; }
        const float rstd = rsqrtf(wave_sum(s2) * (1.0f / 512.0f) + EPS);
#pragma unroll
        for (int q = 0; q < 8; ++q) v[q] = v[q] * rstd * lng[c0 + q] + lnb[c0 + q];
        u32x4 o; o.x = pk2(v[0], v[1]); o.y = pk2(v[2], v[3]); o.z = pk2(v[4], v[5]); o.w = pk2(v[6], v[7]);
        *(LAS u32x4*)(lds + LDS_V + (lane >> 2) * 8192 + j * 64 + (lane & 3) * 16) = o;
    }
    __syncthreads();
    const int h = w >> 1, ih = w & 1;
    f32x16 acc[4][2];
#pragma unroll
    for (int ct = 0; ct < 4; ++ct)
#pragma unroll
        for (int it = 0; it < 2; ++it) acc[ct][it] = (f32x16){};
    const LAS unsigned char* vb = lds + LDS_V + (4 * h) * 8192 + (4 * hi + ((lane & 15) >> 2)) * 64 + ((lane >> 4) & 1) * 32 + (lane & 3) * 8;
    const bf16* wrow = wsb + ((size_t)h * 128 + 64 * ih + r32) * 128 + 4 * hi;
    const int nks = ih ? 8 : 4;
#pragma unroll 1
    for (int ks = 0; ks < nks; ++ks) {
        bf16x8 bfr[2];
#pragma unroll
        for (int it = 0; it < 2; ++it) { const u32x2 b0 = *(const u32x2*)(wrow + (32 * it) * 128 + 16 * ks), b1 = *(const u32x2*)(wrow + (32 * it) * 128 + 16 * ks + 8);
            bfr[it] = __builtin_bit_cast(bf16x8, (u32x4){b0.x, b0.y, b1.x, b1.y}); }
#pragma unroll
        for (int ct = 0; ct < 4; ++ct) { const s16x4 lo = at::vtr(vb + ct * 8192 + (16 * ks) * 64), hh = at::vtr(vb + ct * 8192 + (16 * ks + 8) * 64);
            const bf16x8 afr = (bf16x8){lo[0], lo[1], lo[2], lo[3], hh[0], hh[1], hh[2], hh[3]};
#pragma unroll
            for (int it = 0; it < 2; ++it) acc[ct][it] = __builtin_amdgcn_mfma_f32_32x32x16_bf16(afr, bfr[it], acc[ct][it], 0, 0, 0); }
    }
#pragma unroll
    for (int it = 0; it < 2; ++it) { const int i = 64 * ih + 32 * it + r32; const float bsv = sb[h * 128 + i]; float ss = 0.f;
        const bf16* srow = proj + (size_t)(t0 + i) * PW + C_SU + h * 128 + 4 * hi;
#pragma unroll
        for (int ct = 0; ct < 4; ++ct)
#pragma unroll
            for (int rq = 0; rq < 4; ++rq) { const u32x2 uv = *(const u32x2*)(srow + 32 * ct + 8 * rq);
                float v;
                v = gelu_tanh(bflo(uv.x)) * (acc[ct][it][4 * rq + 0] + bsv); acc[ct][it][4 * rq + 0] = v; ss += v * v;
                v = gelu_tanh(bfhi(uv.x)) * (acc[ct][it][4 * rq + 1] + bsv); acc[ct][it][4 * rq + 1] = v; ss += v * v;
                v = gelu_tanh(bflo(uv.y)) * (acc[ct][it][4 * rq + 2] + bsv); acc[ct][it][4 * rq + 2] = v; ss += v * v;
                v = gelu_tanh(bfhi(uv.y)) * (acc[ct][it][4 * rq + 3] + bsv); acc[ct][it][4 * rq + 3] = v; ss += v * v; }
        ss = swap_sum(ss);
        if (hi == 0) red[h * 128 + i] = ss; }
    __syncthreads();
#pragma unroll
    for (int it = 0; it < 2; ++it) { const int i = 64 * ih + 32 * it + r32;
        const float tot = (red[i] + red[128 + i]) + (red[256 + i] + red[384 + i]);
        const float rstd = rsqrtf(tot * (1.0f / 512.0f) + EPS);
        bf16* orow = mix + (size_t)(t0 + i) * D + 1024 + h * 128 + 4 * hi; const float* gp = mixg + h * 128 + 4 * hi;
#pragma unroll
        for (int ct = 0; ct < 4; ++ct)
#pragma unroll
            for (int rq = 0; rq < 4; ++rq) { const f32x4 gq = *(const f32x4*)(gp + 32 * ct + 8 * rq);
                u32x2 wv; wv.x = gm::cvt_pk_bf16(acc[ct][it][4 * rq + 0] * rstd * gq.x, acc[ct][it][4 * rq + 1] * rstd * gq.y); wv.y = gm::cvt_pk_bf16(acc[ct][it][4 * rq + 2] * rstd * gq.z, acc[ct][it][4 * rq + 3] * rstd * gq.w);
                *(u32x2*)(orow + 32 * ct + 8 * rq) = wv; } }
    __syncthreads();
}
}

namespace rt {
constexpr int LDS_PART = 0, LDS_SEL = 32768, LDS_SC = LDS_SEL + 64 * 65 * 4, LDS_E = LDS_SC + 64 * 65 * 4, LDS_R = LDS_E + 64 * 8 * 4;
__device__ __forceinline__ void ln_router_tile(const Frame& F, const bf16* yf, const float* g1, const float* b1, bf16* x1b, bf16* x1l, unsigned char* x1q, const bf16* __restrict__ rthi, const bf16* __restrict__ rtlo,
                                               const float* rbias, int* selE, float* selW, int* selR, int* cnt, int tile) {
    int tid = F.wave * 64 + lane_id(); asm volatile("" : "+v"(tid));
    LAS unsigned char* lds = F.lds; const int lane = tid & 63, w = F.wave, r32 = lane & 31, hi = lane >> 5, t0 = 64 * tile;
    for (int rp1 = 0; rp1 < 1 + ((REPMASK >> 15) & 1); ++rp1)
#pragma unroll 1
    for (int rq = 0; rq < 8; rq += 4) {
    u32x2 yraw[4][8];
#pragma unroll
    for (int r4 = 0; r4 < 4; ++r4) { const u32x2* yr = (const u32x2*)(yf + (size_t)(t0 + 8 * w + rq + r4) * D) + lane;
#pragma unroll
        for (int j = 0; j < 8; ++j) yraw[r4][j] = yr[64 * j]; }
#pragma unroll
    for (int r4 = 0; r4 < 4; ++r4) {
        const int t = t0 + 8 * w + rq + r4;
        f32x4 v[8]; float s = 0.f;
#pragma unroll
        for (int j = 0; j < 8; ++j) { const u32x2 y = yraw[r4][j]; v[j] = (f32x4){bflo(y.x), bfhi(y.x), bflo(y.y), bfhi(y.y)}; s += (v[j].x + v[j].y) + (v[j].z + v[j].w); }
        const float mean = wave_sum(s) * (1.0f / D); float s2 = 0.f;
#pragma unroll
        for (int j = 0; j < 8; ++j) { v[j] = v[j] - mean; s2 += (v[j].x * v[j].x + v[j].y * v[j].y) + (v[j].z * v[j].z + v[j].w * v[j].w); }
        const float rstd = rsqrtf(wave_sum(s2) * (1.0f / D) + EPS);
#pragma unroll
        for (int j = 0; j < 8; ++j) { const int c = 4 * lane + 256 * j; const f32x4 gg = *(const f32x4*)(g1 + c), bb = *(const f32x4*)(b1 + c);
            const f32x4 o = v[j] * rstd * gg + bb;
            u32x2 wh; wh.x = pk2(o.x, o.y); wh.y = pk2(o.z, o.w); *(u32x2*)(x1b + (size_t)t * D + c) = wh;
            u32x2 wl; wl.x = pk2(o.x - bflo(wh.x), o.y - bfhi(wh.x)); wl.y = pk2(o.z - bflo(wh.y), o.w - bfhi(wh.y)); *(u32x2*)(x1l + (size_t)t * D + c) = wl;
            if (x1q) *(unsigned*)(x1q + (size_t)t * D + c) = pk4_fp8(o.x, o.y, o.z, o.w); }
    }
    }
    __threadfence_block();
    __syncthreads();
    for (int rp2 = 0; rp2 < 1 + ((REPMASK >> 16) & 1); ++rp2)
    { const int tt = w >> 2, et = (w >> 1) & 1, kh = w & 1;
      asm volatile("" ::: "memory");
      f32x16 acc = (f32x16){};
      const int mm = w >> 1; const bf16* mbase = (mm == 0) ? x1b + (size_t)t0 * D : (mm == 1) ? x1l + (size_t)t0 * D : (mm == 2) ? rthi : rtlo;
      const bf16* gp[4];
#pragma unroll
      for (int i = 0; i < 4; ++i) { const int row = 32 * (w & 1) + 8 * i + (lane >> 3); gp[i] = mbase + (size_t)row * D + 8 * ((lane & 7) ^ ((row >> 1) & 7)); }
      const unsigned dbase = (unsigned)mm * 8192u + (unsigned)(w & 1) * 4096u;
#define RT_DMA(c) do { _Pragma("unroll") for (int i = 0; i < 4; ++i) \
          __builtin_amdgcn_global_load_lds((const unsigned*)(gp[i] + 64 * (c)), (LAS unsigned*)(lds + ((c) & 3) * 32768 + dbase + i * 1024), 16, 0, 0); } while (0)
      RT_DMA(0); RT_DMA(1); RT_DMA(2);
      const int ra = 32 * tt + r32, rb = 32 * et + r32, sa = (ra >> 1) & 7, sb = (rb >> 1) & 7;
#pragma unroll 1
      for (int c = 0; c < 32; ++c) {
          if (c < 30) asm volatile("s_waitcnt vmcnt(8)" ::: "memory"); else if (c == 30) asm volatile("s_waitcnt vmcnt(4)" ::: "memory"); else asm volatile("s_waitcnt vmcnt(0)" ::: "memory");
          asm volatile("s_waitcnt lgkmcnt(0)" ::: "memory");
          __builtin_amdgcn_s_barrier();
          asm volatile("" ::: "memory"); __builtin_amdgcn_sched_barrier(0);
          if (c + 3 < 32) RT_DMA(c + 3);
          const LAS unsigned char* bb = lds + (c & 3) * 32768;
#pragma unroll
          for (int s2 = 0; s2 < 2; ++s2) { const int ch = 2 * (2 * kh + s2) + hi;
              const bf16x8 a_h = *(const LAS bf16x8*)(bb + ra * 128 + ((ch ^ sa) * 16)), a_l = *(const LAS bf16x8*)(bb + 8192 + ra * 128 + ((ch ^ sa) * 16));
              const bf16x8 b_h = *(const LAS bf16x8*)(bb + 16384 + rb * 128 + ((ch ^ sb) * 16)), b_l = *(const LAS bf16x8*)(bb + 24576 + rb * 128 + ((ch ^ sb) * 16));
              acc = __builtin_amdgcn_mfma_f32_32x32x16_bf16(a_l, b_h, acc, 0, 0, 0); acc = __builtin_amdgcn_mfma_f32_32x32x16_bf16(a_h, b_l, acc, 0, 0, 0); acc = __builtin_amdgcn_mfma_f32_32x32x16_bf16(a_h, b_h, acc, 0, 0, 0); }
          asm volatile("" ::: "memory");
      }
#undef RT_DMA
      asm volatile("s_waitcnt lgkmcnt(0)" ::: "memory");
      __builtin_amdgcn_s_barrier();
      asm volatile("" ::: "memory");
      LAS float* part = (LAS float*)(lds + LDS_PART) + kh * 4096;
#pragma unroll
      for (int r = 0; r < 16; ++r) part[(32 * tt + crow(r, hi)) * 64 + 32 * et + r32] = acc[r];
    }
    __syncthreads();
    LAS float* sel = (LAS float*)(lds + LDS_SEL); LAS float* sc = (LAS float*)(lds + LDS_SC); LAS int* sE = (LAS int*)(lds + LDS_E); LAS int* sR = (LAS int*)(lds + LDS_R);
    { const LAS float* part = (const LAS float*)(lds + LDS_PART);
      for (int i = tid; i < 4096; i += NTHR) { const int t = i >> 6, e = i & 63; const float s = sigmoid_div(part[i] + part[4096 + i]); sc[t * 65 + e] = s; sel[t * 65 + e] = s + rbias[e]; } }
    __syncthreads();
    LAS unsigned* mk = (LAS unsigned*)(lds + LDS_R + 2048);
    if (tid < 128) mk[tid] = 0u;
    {
        const int tl = lane >> 3, g = lane & 7, t = 8 * w + tl; const LAS float* sl = sel + t * 65 + 8 * g;
        float v[8];
#pragma unroll
        for (int q = 0; q < 8; ++q) v[q] = sl[q];
        float m1 = -INFINITY, m2 = -INFINITY;
#pragma unroll
        for (int q = 0; q < 8; ++q) { if (v[q] > m1) { m2 = m1; m1 = v[q]; } else if (v[q] > m2) m2 = v[q]; }
        const float gs = m1 + m2; int rank = 0;
#pragma unroll
        for (int d = 1; d < 8; ++d) { const int og = (g + d) & 7; const float o = shfl_xor_l(gs, lane, g ^ og); rank += (o > gs || (o == gs && og < g)) ? 1 : 0; }
        if (rank >= 4) {
#pragma unroll
            for (int q = 0; q < 8; ++q) v[q] = -INFINITY; }
        float wsum = 0.f, myw = 0.f; int mye = 0;
#pragma unroll
        for (int k = 0; k < 8; ++k) {
            float bv = v[0]; int bi = 8 * g;
#pragma unroll
            for (int q = 1; q < 8; ++q) if (v[q] > bv) { bv = v[q]; bi = 8 * g + q; }
#pragma unroll
            for (int x = 1; x < 8; x <<= 1) { const float ov = shfl_xor_l(bv, lane, x); const int oi = __builtin_bit_cast(int, shfl_xor_l(__builtin_bit_cast(float, bi), lane, x));
                if (ov > bv || (ov == bv && oi < bi)) { bv = ov; bi = oi; } }
#pragma unroll
            for (int q = 0; q < 8; ++q) if (bi == 8 * g + q) v[q] = -INFINITY;
            const float sv = sc[t * 65 + bi]; wsum += sv;
            if (g == k) { myw = sv; mye = bi; }
        }
        const float sc_ = 2.5f / (wsum + 1e-20f);
        sE[t * 8 + g] = mye; selE[(size_t)(t0 + t) * 8 + g] = mye; selW[(size_t)(t0 + t) * 8 + g] = myw * sc_;
    }
    __syncthreads();
    { const int t = tid >> 3; const int e = sE[tid]; __hip_atomic_fetch_or(mk + 2 * e + (t >> 5), 1u << (t & 31), __ATOMIC_RELAXED, __HIP_MEMORY_SCOPE_WORKGROUP); }
    __syncthreads();
    { const int t = tid >> 3; const int e = sE[tid]; const unsigned lo_ = mk[2 * e], hi2 = mk[2 * e + 1];
      const int rk = (t < 32) ? __builtin_popcount(lo_ & ((1u << t) - 1u)) : __builtin_popcount(lo_) + __builtin_popcount(hi2 & ((1u << (t - 32)) - 1u));
      selR[(size_t)t0 * 8 + tid] = rk; }
    if (tid < 64) cnt[tile * 64 + tid] = __builtin_popcount(mk[2 * tid]) + __builtin_popcount(mk[2 * tid + 1]);
    __syncthreads();
}
}

namespace sc {
__device__ __forceinline__ void scatter_tile(const Frame& F, const int* cnt, const int* selE, const int* selR, int* rowtok, int* slot, int* etab, int tile) {
    LAS int* ps = (LAS int*)F.lds;
    int tid = F.wave * 64 + lane_id(); asm volatile("" : "+v"(tid));
    const int e = tid & 63, q = tid >> 6;
    { int tot = 0, off = 0; int cv[32];
#pragma unroll
      for (int i = 0; i < 32; ++i) cv[i] = cnt[(q + 8 * i) * 64 + e];
#pragma unroll
      for (int i = 0; i < 32; ++i) { tot += cv[i]; off += (q + 8 * i < tile) ? cv[i] : 0; }
      ps[q * 64 + e] = tot; ps[512 + q * 64 + e] = off; }
    __syncthreads();
    if (tid < 64) { int tot = 0, off = 0;
#pragma unroll
        for (int k = 0; k < 8; ++k) { tot += ps[k * 64 + tid]; off += ps[512 + k * 64 + tid]; }
        ps[1024 + tid] = tot; ps[1088 + tid] = off; }
    __syncthreads();
    if (tid == 0) { int tp = 0;
        for (int k = 0; k < 64; ++k) { ps[1152 + k] = tp; tp += (ps[1024 + k] + 255) >> 8; }
        ps[1152 + 64] = tp; ps[1152 + 65] = tp + 64; }
    __syncthreads();
    if (tile == 0 && tid < 66) etab[tid] = ps[1152 + tid];
    { const int t = tid >> 3, k = tid & 7, tg = tile * 64 + t; const int ee = selE[(size_t)tg * 8 + k]; const int pos = ps[1152 + ee] * 256 + ps[1088 + ee] + selR[(size_t)tg * 8 + k];
      rowtok[pos] = tg; slot[(size_t)tg * 8 + k] = pos; }
    if (tid < 64) rowtok[ps[1152 + 64] * 256 + tile * 64 + tid] = tile * 64 + tid;
    if (tile < 64) { const int b0 = ps[1152 + tile] * 256 + ps[1024 + tile], b1 = ps[1152 + tile + 1] * 256;
        for (int p = b0 + tid; p < b1; p += NTHR) rowtok[p] = 0; }
    __syncthreads();
}
}

template <bool YS8>
__device__ __forceinline__ void combine_row(const Frame& F, const bf16* __restrict__ ys, const int* slot, const float* selW, const bf16* x1b, const float* g2, const float* b2, float* xout, bf16* xb, int sh_base, int t, bool last) {
    int lane = lane_id(); asm volatile("" : "+v"(lane));
    LAS float* vs = (LAS float*)(F.lds + F.wave * 8192) + lane * 8;
    constexpr int YB = YS8 ? 1 : 2;
    unsigned ro[9]; float wk[9];
#pragma unroll
    for (int k = 0; k < 8; ++k) { ro[k] = (unsigned)slot[(size_t)t * 8 + k] * (unsigned)(D * YB); wk[k] = selW[(size_t)t * 8 + k] * (YS8 ? 1.0f / YS8SCALE : 1.0f); }
    ro[8] = (unsigned)(sh_base + t) * (unsigned)(D * YB); wk[8] = YS8 ? 1.0f / YS8SCALE : 1.0f;
    const char* ysb = (const char*)ys + 8 * YB * lane; const bf16* xr = x1b + (size_t)t * D + 8 * lane;
    float s = 0.f;
    u32x2 y8[YS8 ? 4 : 1][9]; u32x4 xq4[YS8 ? 4 : 1];
    if constexpr (YS8) {
#pragma unroll
        for (int j = 0; j < 4; ++j) {
#pragma unroll
            for (int k = 0; k < 9; ++k) y8[j][k] = *(const u32x2*)(ysb + ro[k] + 512 * j);
            xq4[j] = *(const u32x4*)(xr + 512 * j); }
    }
#pragma unroll
    for (int j = 0; j < 4; ++j) {
        float a[8] = {0.f, 0.f, 0.f, 0.f, 0.f, 0.f, 0.f, 0.f};
        if constexpr (YS8) {
            const u32x2 (&y)[9] = y8[j];
#pragma unroll
            for (int k = 0; k < 9; ++k) { const f32x2 q0 = __builtin_amdgcn_cvt_pk_f32_fp8((int)y[k].x, false), q1 = __builtin_amdgcn_cvt_pk_f32_fp8((int)y[k].x, true), q2 = __builtin_amdgcn_cvt_pk_f32_fp8((int)y[k].y, false), q3 = __builtin_amdgcn_cvt_pk_f32_fp8((int)y[k].y, true);
                a[0] += q0.x * wk[k]; a[1] += q0.y * wk[k]; a[2] += q1.x * wk[k]; a[3] += q1.y * wk[k]; a[4] += q2.x * wk[k]; a[5] += q2.y * wk[k]; a[6] += q3.x * wk[k]; a[7] += q3.y * wk[k]; }
        } else {
            u32x4 y[9];
#pragma unroll
            for (int k = 0; k < 9; ++k) y[k] = *(const u32x4*)(ysb + ro[k] + 1024 * j);
#pragma unroll
            for (int k = 0; k < 9; ++k) { a[0] += bflo(y[k].x) * wk[k]; a[1] += bfhi(y[k].x) * wk[k]; a[2] += bflo(y[k].y) * wk[k]; a[3] += bfhi(y[k].y) * wk[k];
                a[4] += bflo(y[k].z) * wk[k]; a[5] += bfhi(y[k].z) * wk[k]; a[6] += bflo(y[k].w) * wk[k]; a[7] += bfhi(y[k].w) * wk[k]; }
        }
        u32x4 xq; if constexpr (YS8) xq = xq4[j]; else xq = *(const u32x4*)(xr + 512 * j);
        const f32x4 xa = (f32x4){bflo(xq.x), bfhi(xq.x), bflo(xq.y), bfhi(xq.y)}, xb4 = (f32x4){bflo(xq.z), bfhi(xq.z), bflo(xq.w), bfhi(xq.w)};
        const f32x4 va = xa * ALPHA + (f32x4){a[0], a[1], a[2], a[3]}, vb = xb4 * ALPHA + (f32x4){a[4], a[5], a[6], a[7]};
        *(LAS f32x4*)(vs + 512 * j) = va; *(LAS f32x4*)(vs + 512 * j + 4) = vb;
        s += ((va.x + va.y) + (va.z + va.w)) + ((vb.x + vb.y) + (vb.z + vb.w)); }
    const float mean = wave_sum(s) * (1.0f / D); float s2 = 0.f;
#pragma unroll
    for (int j = 0; j < 4; ++j) { const f32x4 va = *(const LAS f32x4*)(vs + 512 * j) - mean, vb = *(const LAS f32x4*)(vs + 512 * j + 4) - mean;
        s2 += ((va.x * va.x + va.y * va.y) + (va.z * va.z + va.w * va.w)) + ((vb.x * vb.x + vb.y * vb.y) + (vb.z * vb.z + vb.w * vb.w)); }
    const float rstd = rsqrtf(wave_sum(s2) * (1.0f / D) + EPS);
    float* orow = xout + (size_t)t * D + 8 * lane; bf16* brow = xb + (size_t)t * D + 8 * lane;
#pragma unroll 1
    for (int j = 0; j < 4; ++j) { const int c = 8 * lane + 512 * j;
        const f32x4 ga = *(const f32x4*)(g2 + c), gb = *(const f32x4*)(g2 + c + 4), ba = *(const f32x4*)(b2 + c), bb = *(const f32x4*)(b2 + c + 4);
        const f32x4 oa = (*(const LAS f32x4*)(vs + 512 * j) - mean) * rstd * ga + ba, ob = (*(const LAS f32x4*)(vs + 512 * j + 4) - mean) * rstd * gb + bb;
        if (last) { *(f32x4*)(orow + 512 * j) = oa; *(f32x4*)(orow + 512 * j + 4) = ob; }
        u32x4 wv; wv.x = pk2(oa.x, oa.y); wv.y = pk2(oa.z, oa.w); wv.z = pk2(ob.x, ob.y); wv.w = pk2(ob.z, ob.w); *(u32x4*)(brow + 512 * j) = wv; }
}

constexpr int NPPL = 10, NPH = 1 + NPPL * DEPTH, CONV_LO = 8192;
__global__ void __launch_bounds__(NTHR, 2) fwd(Args args) {
    extern __shared__ __attribute__((aligned(16))) unsigned char lds_raw[];
    Frame F;
    F.lds = (LAS unsigned char*)lds_raw;
    F.wave = __builtin_amdgcn_readfirstlane(threadIdx.x >> 6);
    F.G = gridDim.x; { const int bx = blockIdx.x; F.vcu = (F.G % 8 == 0) ? (bx % 8) * (F.G / 8) + bx / 8 : bx; }
    volatile LAS unsigned* MISC = (volatile LAS unsigned*)(F.lds + LDS_MISC);
    if (threadIdx.x < 64) MISC[threadIdx.x] = 0u;
    __syncthreads();
    typedef const __attribute__((address_space(4))) Args* KArgs;
#define PHASE_ENV() KArgs ka = (KArgs)__builtin_amdgcn_kernarg_segment_ptr(); asm volatile("" : "+s"(ka)); unsigned char* const ws = ka->ws; (void)ws; \
    Frame Fp; Fp.lds = F.lds; { int w_ = F.wave, v_ = F.vcu, g_ = F.G; asm volatile("" : "+s"(w_), "+s"(v_), "+s"(g_)); Fp.wave = w_; Fp.vcu = v_; Fp.G = g_; } \
    const int gw = Fp.vcu * NWAVES + Fp.wave, NGW = Fp.G * NWAVES; (void)gw; (void)NGW
#define XB_   ((bf16*)(ws + WS_XB))
#define PROJ_ ((bf16*)(ws + WS_PROJ))
#define MIX_  ((bf16*)(ws + WS_MIX))
#define YFB_  ((bf16*)(ws + WS_YF))
#define X1Q_  ((unsigned char*)(ws + WS_X1F))
#define X1B_  ((bf16*)(ws + WS_X1B))
#define X1L_  ((bf16*)(ws + WS_X1L))
#define HB_   ((bf16*)(ws + WS_H))
#define YS_   ((bf16*)(ws + WS_YS))
#define ETAB_ ((int*)(ws + WS_ETAB))
#define CNT_  ((int*)(ws + WS_CNT))
#define SELE_ ((int*)(ws + WS_SELE))
#define SELW_ ((float*)(ws + WS_SELW))
#define SELR_ ((int*)(ws + WS_SELR))
#define SLOT_ ((int*)(ws + WS_SLOT))
#define ROWTOK_ ((int*)(ws + WS_ROWTOK))
#define S5E_  ((f32x2*)(ws + WS_S5E))
#define S5IN_ ((f32x2*)(ws + WS_S5IN))
#define S5TAB_ (ws + WS_S5TAB + (size_t)l * S5TAB_STRIDE)
#define MIXG_ (ka->in[3] + l * 1536)
#if MK_ONE_LAUNCH
    XcdBarrier bar = xcd_barrier_post((unsigned*)(args.ws + WS_CTL) + CW_BAR, MISC + 8);
#define GRID_BAR() do { xcd_barrier(bar); if ((REPMASK >> 17) & 1) xcd_barrier(bar); } while (0)
#else
#define GRID_BAR() do { } while (0)
#endif
    const int lo = args.ph_lo, hi_ = args.ph_hi;
#ifndef PHMASK
#define PHMASK 0x7fff
#endif
#define EN(j) (((PHMASK) >> (j)) & 1)
#ifndef REPMASK
#define REPMASK 0
#endif
#define REP(j) for (int rep_ = 0; rep_ < 1 + (((REPMASK) >> (j)) & 1); ++rep_)
#define IN(k) (lo <= (k) && (k) < hi_)
#define BOTH(k) (IN(k) && IN((k) + 1))

    if (EN(0) && IN(0)) { REP(0) p0_prologue(F, args); if (BOTH(0)) GRID_BAR(); }

    for (int l = 0; l < DEPTH; ++l) {
        const int pb = 1 + NPPL * l;
        if (EN(1) && IN(pb + 0)) {
            PHASE_ENV(); int bx_ = blockIdx.x; asm volatile("" : "+s"(bx_));
            gm::Gemm g{XB_, (const bf16*)(ws + WS_WIN) + (size_t)l * PW * D, D, nullptr, 0};
            gm::DenseOrder S; gm::EpiBf16 E{PROJ_, PW, 1.0f};
            const bool ovl = (l == 0 && Fp.G == 256);
            if (ovl) S.init(T, C_Q, 128, bx_ - 128); else S.init(T, C_Q, Fp.G, bx_);
            if (ovl && bx_ < 128) convert_items(Fp, TI_WIN, TI_TOTAL - TI_DEFER - TI_GTAIL, bx_ * NWAVES + Fp.wave, 128 * NWAVES);
            else { REP(1) gm::gemm_phase<gm::EpiBf16, gm::DenseOrder, false>(Fp.lds, Fp.wave, g, S, E);
                if (ovl) {
                    gm::Gemm g2{XB_, (const bf16*)(ws + WS_WIN) + (size_t)l * PW * D + (size_t)C_Q * D, D, nullptr, 0};
                    gm::DenseOrder S2; S2.init(T, PW - C_Q, 128, bx_ - 128);
                    gm::EpiBf16 E2{PROJ_ + C_Q, PW, 1.0f};
                    gm::gemm_phase<gm::EpiBf16, gm::DenseOrder, false>(Fp.lds, Fp.wave, g2, S2, E2);
                    convert_items(Fp, TI_TOTAL - TI_DEFER - TI_GTAIL, TI_TOTAL - TI_DEFER, (bx_ - 128) * NWAVES + Fp.wave, 128 * NWAVES); } }
            if (BOTH(pb + 0)) GRID_BAR();
        }
        if (EN(2) && IN(pb + 1)) {
            PHASE_ENV(); int bx_ = blockIdx.x; asm volatile("" : "+s"(bx_));
            const bool l0 = (l == 0 && Fp.G == 256);
            if (EN(1) && !l0) {
                gm::Gemm g{XB_, (const bf16*)(ws + WS_WIN) + (size_t)l * PW * D + (size_t)C_Q * D, D, nullptr, 0};
                gm::DenseOrder S; S.init(T, PW - C_Q, Fp.G, bx_);
                gm::EpiBf16 E{PROJ_ + C_Q, PW, 1.0f};
                REP(1) gm::gemm_phase<gm::EpiBf16, gm::DenseOrder, false>(Fp.lds, Fp.wave, g, S, E);
            }
            const bool split = (Fp.G == 256); const int half = Fp.G >> 1;
            const bool hiw = split && bx_ >= half;
            if (EN(10) && !(l0 && hiw)) REP(10) for (int c = split ? bx_ : Fp.vcu; c < 256; c += l0 ? half : Fp.G) {
                int lane_ = lane_id(); asm volatile("" : "+v"(lane_));
#pragma unroll 1
                for (int gi = 0; gi < 4; ++gi) s5::s5_group<false>(lane_, S5TAB_, PROJ_, S5E_, c, 4 * Fp.wave + gi, nullptr, nullptr);
            }
            if (EN(11)) REP(11) {
                const int clo = l0 ? 12288 : CONV_LO; const int t_lo = !split ? 0 : hiw ? clo : 0, t_hi = !split ? T : hiw ? T : clo, idx = !split ? Fp.vcu : hiw ? bx_ - half : bx_, cnt = split ? half : Fp.G;
#pragma unroll 2
                for (int t = t_lo + idx * NWAVES + Fp.wave; t < t_hi; t += cnt * NWAVES) conv_row(Fp, PROJ_, ka->in[13] + (size_t)l * 3 * GW, MIXG_ + 512, MIX_, t);
            }
            if (EN(12) && (!split || hiw)) REP(12) for (int blk = split ? bx_ - half : Fp.vcu; blk < 128; blk += split ? half : Fp.G)
                sgu::sgu_block(Fp, PROJ_, ka->in[14] + l * GW, ka->in[15] + l * GW, (const bf16*)(ws + WS_SGUW) + (size_t)l * 65536, ka->in[17] + l * 512, MIXG_ + 1024, MIX_, blk);
            if (l == 0) { __syncthreads(); convert_items(Fp, TI_TOTAL - TI_DEFER, TI_TOTAL, gw, NGW); }
            if (BOTH(pb + 1)) GRID_BAR();
        }
        if (EN(2) && IN(pb + 2)) {
            PHASE_ENV();
            if (EN(14)) REP(14) for (int g = Fp.vcu; g < 32; g += Fp.G) { int lane_ = lane_id(); asm volatile("" : "+v"(lane_)); s5::s5_carry_scan_par(S5TAB_, S5E_, S5IN_, g, lane_, Fp.wave, Fp.lds); __syncthreads(); }
            if (EN(13)) {
                int ln_ = lane_id(); asm volatile("" : "+v"(ln_));
                float d1 = ka->in[18][l * 64 + ln_] * ka->in[19][l * 64 + ln_], d2 = ka->in[20][l * 64 + ln_] * ka->in[21][l * 64 + ln_];
                d1 = wave_sum(d1); d2 = wave_sum(d2);
                const float lam_init = (l == 0) ? 0.2f : 0.35550906f;
                const float lam = expf(d1) - expf(d2) + lam_init;
                REP(13) for (int p = Fp.vcu; p < 256; p += Fp.G) { const int h = p >> 6, s = p & 63;
#pragma unroll 1
                    for (int u2 = 0; u2 < 2; ++u2) at::attn_unit(Fp, PROJ_, MIX_, ka->in[23], ka->in[22] + l * 128, h, u2 ? s : 127 - s, lam, 1.0f - lam_init); }
            }
            if (BOTH(pb + 2)) GRID_BAR();
        }
        if (EN(3) && IN(pb + 3)) {
            PHASE_ENV();
            REP(3) for (int c = Fp.vcu; c < 256; c += Fp.G)
                s5::s5_final_chunk(Fp, S5TAB_, PROJ_, S5IN_, (const bf16*)(ws + WS_WGLU) + (size_t)l * GW * GW, MIXG_, MIX_, c);
            if (BOTH(pb + 3)) GRID_BAR();
        }
        if (EN(4) && IN(pb + 4)) {
            PHASE_ENV(); int bx_ = blockIdx.x; asm volatile("" : "+s"(bx_));
            gm::Gemm g{MIX_, (const bf16*)(ws + WS_WOUT) + (size_t)l * D * D, D, nullptr, 0};
            gm::DenseOrder S; S.init(T, D, Fp.G, bx_);
            gm::EpiResBf16 E{YFB_, XB_, D, ALPHA};
            REP(4) gm::gemm_phase<gm::EpiResBf16, gm::DenseOrder, false>(Fp.lds, Fp.wave, g, S, E);
            if (BOTH(pb + 4)) GRID_BAR();
        }
        if (EN(5) && IN(pb + 5)) {
            PHASE_ENV();
            REP(5) for (int tile = Fp.vcu; tile < 256; tile += Fp.G)
                rt::ln_router_tile(Fp, YFB_, ka->in[24] + l * D, ka->in[25] + l * D, X1B_, X1L_, (l >= FP8_FIRST) ? X1Q_ : nullptr, (const bf16*)(ws + WS_RT) + (size_t)l * 2 * NEXP * D, (const bf16*)(ws + WS_RT) + (size_t)l * 2 * NEXP * D + (size_t)NEXP * D,
                                   ka->in[27] + l * NEXP, SELE_, SELW_, SELR_, CNT_, tile);
            if (BOTH(pb + 5)) GRID_BAR();
        }
        if (EN(6) && IN(pb + 6)) {
            PHASE_ENV();
            REP(6) for (int tile = Fp.vcu; tile < 256; tile += Fp.G) sc::scatter_tile(Fp, CNT_, SELE_, SELR_, ROWTOK_, SLOT_, ETAB_, tile);
            if (BOTH(pb + 6)) GRID_BAR();
        }
        if (EN(7) && IN(pb + 7)) {
            PHASE_ENV();
            LAS int* tp = (LAS int*)(Fp.lds + LDS_MISC - 512);
            { int t_ = Fp.wave * 64 + lane_id(); asm volatile("" : "+v"(t_)); if (t_ < 66) tp[t_] = ETAB_[t_]; }
            __syncthreads();
            if (l >= FP8_FIRST) {
                gm::Gemm g{X1Q_, ws + WS_WGU + (size_t)l * NE1 * 1024 * D * 2, D, ROWTOK_, (size_t)1024 * D};
                gm::GroupOrder S{tp, 4, Fp.G, Fp.vcu, 0};
                gm::EpiSwiGlu<(DOWN_FP8 != 0)> E{HB_, 1.0f / W8SCALE};
                REP(7) { S.ecur = 0; gm::gemm_phase<gm::EpiSwiGlu<(DOWN_FP8 != 0)>, gm::GroupOrder, true, true>(Fp.lds, Fp.wave, g, S, E); }
            } else {
                gm::Gemm g{X1B_, ws + WS_WGU + (size_t)l * NE1 * 1024 * D * 2, D, ROWTOK_, (size_t)1024 * D * 2};
                gm::GroupOrder S{tp, 4, Fp.G, Fp.vcu, 0};
                gm::EpiSwiGlu<false> E{HB_, 1.0f};
                REP(7) { S.ecur = 0; gm::gemm_phase<gm::EpiSwiGlu<false>, gm::GroupOrder, true, false>(Fp.lds, Fp.wave, g, S, E); }
            }
            if (BOTH(pb + 7)) GRID_BAR();
        }
        if (EN(8) && IN(pb + 8)) {
            PHASE_ENV();
            LAS int* tp = (LAS int*)(Fp.lds + LDS_MISC - 512);
            { int t_ = Fp.wave * 64 + lane_id(); asm volatile("" : "+v"(t_)); if (t_ < 66) tp[t_] = ETAB_[t_]; }
            __syncthreads();
            if (DOWN_FP8 && l >= FP8_FIRST) {
                gm::Gemm g{HB_, ws + WS_WDN + (size_t)l * NE1 * D * DEXP * 2, DEXP, nullptr, (size_t)D * DEXP};
                gm::GroupOrder S{tp, 8, Fp.G, Fp.vcu, 0};
                gm::EpiStore<true> E{YS_, D, YS8SCALE / W8SCALE};
                REP(8) { S.ecur = 0; gm::gemm_phase<gm::EpiStore<true>, gm::GroupOrder, false, true>(Fp.lds, Fp.wave, g, S, E); }
            } else {
                gm::Gemm g{HB_, ws + WS_WDN + (size_t)l * NE1 * D * DEXP * 2, DEXP, nullptr, (size_t)D * DEXP * 2};
                gm::GroupOrder S{tp, 8, Fp.G, Fp.vcu, 0};
                gm::EpiBf16 E{YS_, D, 1.0f};
                REP(8) { S.ecur = 0; gm::gemm_phase<gm::EpiBf16, gm::GroupOrder, false, false>(Fp.lds, Fp.wave, g, S, E); }
            }
            if (BOTH(pb + 8)) GRID_BAR();
        }
        if (EN(9) && IN(pb + 9)) {
            PHASE_ENV();
            const int sh_base = ETAB_[64] * 256;
            if (DOWN_FP8 && l >= FP8_FIRST) { REP(9) for (int t = gw; t < T; t += NGW) combine_row<true>(Fp, YS_, SLOT_, SELW_, X1B_, ka->in[32] + l * D, ka->in[33] + l * D, ka->out, XB_, sh_base, t, l == DEPTH - 1); }
            else { REP(9) for (int t = gw; t < T; t += NGW) combine_row<false>(Fp, YS_, SLOT_, SELW_, X1B_, ka->in[32] + l * D, ka->in[33] + l * D, ka->out, XB_, sh_base, t, l == DEPTH - 1); }
            if (BOTH(pb + 9)) GRID_BAR();
        }
    }
#undef IN
#undef BOTH
}

extern "C" void kernel_launch(void* const* d_in, const int* in_sizes, int n_in, void* d_out, int out_size, void* d_ws, size_t ws_size, hipStream_t stream) {
    static int grid = 0;
    if (grid == 0) {
        if (n_in != 34 || out_size != T * D || ws_size < WS_END) { fprintf(stderr, "kernel_launch: unexpected shapes (n_in %d, out %d, ws %zu < %zu)\n", n_in, out_size, ws_size, (size_t)WS_END); grid = -1; return; }
        int dev = 0, cus = 0, per_cu = 0;
        if (hipGetDevice(&dev) != hipSuccess || hipDeviceGetAttribute(&cus, hipDeviceAttributeMultiprocessorCount, dev) != hipSuccess) { grid = -1; return; }
        if (hipFuncSetAttribute((const void*)fwd, hipFuncAttributeMaxDynamicSharedMemorySize, LDS_BYTES) != hipSuccess) { fprintf(stderr, "kernel_launch: hipFuncSetAttribute failed\n"); grid = -1; return; }
        if (hipOccupancyMaxActiveBlocksPerMultiprocessor(&per_cu, (const void*)fwd, NTHR, LDS_BYTES) != hipSuccess || per_cu < 1) fprintf(stderr, "kernel_launch: occupancy query says %d\n", per_cu);
        (void)hipGetLastError();
        grid = cus;
    }
    if (grid < 0) return;
    (void)hipMemsetAsync((char*)d_ws + WS_CTL, 0, CTL_ZERO_BYTES, stream);
    Args a{};
    for (int i = 0; i < 34; ++i) a.in[i] = (const float*)d_in[i];
    a.out = (float*)d_out; a.ws = (unsigned char*)d_ws;
#if MK_ONE_LAUNCH
    a.ph_lo = 0; a.ph_hi = NPH;
    hipLaunchKernelGGL(fwd, dim3(grid), dim3(NTHR), LDS_BYTES, stream, a);
#else
    for (int p = 0; p < NPH; ++p) { a.ph_lo = p; a.ph_hi = p + 1; hipLaunchKernelGGL(fwd, dim3(grid), dim3(NTHR), LDS_BYTES, stream, a); }
#endif
}
```

```cpp
#include <hip/hip_runtime.h>
#include <cstdio>
#include <cstdint>

#ifndef REPMASK
#define REPMASK 0
#endif
#ifndef DOWN_FP8
#define DOWN_FP8 1
#endif
#ifndef FP8_FIRST
#define FP8_FIRST 0
#endif
#ifndef MK_ONE_LAUNCH
#define MK_ONE_LAUNCH 1
#endif

#define GAS __attribute__((address_space(1)))
#define LAS __attribute__((address_space(3)))
typedef unsigned short bf16;
typedef short bf16x8 __attribute__((ext_vector_type(8)));
typedef short s16x4 __attribute__((ext_vector_type(4)));
typedef float f32x2 __attribute__((ext_vector_type(2)));
typedef float f32x4 __attribute__((ext_vector_type(4)));
typedef float f32x16 __attribute__((ext_vector_type(16)));
typedef unsigned u32x2 __attribute__((ext_vector_type(2)));
typedef unsigned u32x4 __attribute__((ext_vector_type(4)));
typedef GAS unsigned gu32;
typedef int v8i_t __attribute__((ext_vector_type(8)));
typedef short s16x16_t __attribute__((ext_vector_type(16)));

constexpr int T = 16384, D = 2048, PW = 4608, GW = 512, NEXP = 64, NE1 = 65, DEXP = 512, TOPK = 8, DEPTH = 2;
constexpr int RMAX = 163840;
constexpr int C_S5U = 0, C_CB = 512, C_CC = 1024, C_CH = 1536, C_SU = 2048, C_SV = 2560, C_Q = 3072, C_K = 3584, C_V = 4096;
constexpr float ALPHA = 1.4142135623730951f, LOG2E = 1.4426950408889634f, QSCALE = 0.125f * LOG2E, EPS = 1e-5f;
constexpr int NWAVES = 8, NTHR = 512;

constexpr size_t MiB = 1u << 20;
constexpr size_t WS_CTL = 0, CTL_ZERO_BYTES = 1 * MiB;
constexpr size_t WS_ETAB = 1 * MiB;
constexpr size_t WS_CNT = WS_ETAB + 4096;
constexpr size_t WS_SELE = 2 * MiB;
constexpr size_t WS_SELW = WS_SELE + (size_t)T * 8 * 4;
constexpr size_t WS_SELR = WS_SELW + (size_t)T * 8 * 4;
constexpr size_t WS_SLOT = WS_SELR + (size_t)T * 8 * 4;
constexpr size_t WS_ROWTOK = WS_SLOT + (size_t)T * 8 * 4;
constexpr size_t WS_S5E = 6 * MiB;
constexpr size_t WS_S5TAB = 10 * MiB;
constexpr size_t S5TAB_STRIDE = 512 * 1024, S5T_ABAR = 0, S5T_AL = 16384, S5T_BMAT = 32768, S5T_CMAT = 32768 + 131072;
constexpr int CM_PITCH = 144;
constexpr size_t WS_SGUW = 11 * MiB;
constexpr size_t WS_RT = 12 * MiB;
constexpr size_t WS_WIN = 16 * MiB;
constexpr size_t WS_WOUT = WS_WIN + (size_t)2 * PW * D * 2;
constexpr size_t WS_WGLU = WS_WOUT + (size_t)2 * D * D * 2;
constexpr size_t WS_WGU = WS_WGLU + (size_t)2 * GW * GW * 2;
constexpr size_t WS_WDN = WS_WGU + (size_t)2 * NE1 * 1024 * D * 2;
constexpr size_t WS_XB = WS_WDN + (size_t)2 * NE1 * D * DEXP * 2;
constexpr size_t WS_PROJ = WS_XB + (size_t)T * D * 2;
constexpr size_t WS_MIX = WS_PROJ + (size_t)T * PW * 2;
constexpr size_t WS_YF = WS_MIX + (size_t)T * D * 2;
constexpr size_t WS_X1F = WS_YF + (size_t)T * D * 4;
constexpr size_t WS_X1B = WS_X1F + (size_t)T * D * 4;
constexpr size_t WS_X1L = WS_X1B + (size_t)T * D * 2;
constexpr size_t WS_H = WS_X1L + (size_t)T * D * 2;
constexpr size_t WS_YS = WS_H + (size_t)RMAX * DEXP * 2;
constexpr size_t WS_S5IN = WS_YS + (size_t)RMAX * D * 2;
constexpr size_t WS_END = WS_S5IN + 4 * MiB;
static_assert(WS_ROWTOK + (size_t)RMAX * 4 <= WS_S5E, "ws map");
static_assert(WS_WIN % 256 == 0 && WS_WOUT % 256 == 0 && WS_WGU % 256 == 0 && WS_XB % 256 == 0 && WS_YS % 256 == 0, "ws align");

constexpr int CW_TMO = 0;
constexpr int CW_BAR = 4096;

constexpr int LDS_MISC = 147456 - 256;
constexpr int LDS_BYTES = 147456;

#define RLX_AGENT __ATOMIC_RELAXED, __HIP_MEMORY_SCOPE_AGENT
__device__ __forceinline__ unsigned hw_pk_bf16(float lo, float hi) { typedef __bf16 bf16x2_t __attribute__((ext_vector_type(2))); f32x2 v = {lo, hi}; bf16x2_t b = __builtin_convertvector(v, bf16x2_t); return __builtin_bit_cast(unsigned, b); }
__device__ __forceinline__ unsigned f2bf(float f) { return hw_pk_bf16(f, 0.f) & 0xffffu; }
__device__ __forceinline__ float bf2f(unsigned b) { return __builtin_bit_cast(float, b << 16); }
__device__ __forceinline__ unsigned pk2(float lo, float hi) { return hw_pk_bf16(lo, hi); }
__device__ __forceinline__ unsigned pk4_fp8(float a, float b, float c, float d) { int w = __builtin_amdgcn_cvt_pk_fp8_f32(a, b, 0, false); w = __builtin_amdgcn_cvt_pk_fp8_f32(c, d, w, true); return (unsigned)w; }
constexpr float YS8SCALE = 16.0f;
constexpr float W8SCALE = 32.0f;
__device__ __forceinline__ float bflo(unsigned w) { return __builtin_bit_cast(float, w << 16); }
__device__ __forceinline__ float bfhi(unsigned w) { return __builtin_bit_cast(float, w & 0xffff0000u); }
__device__ __forceinline__ int lane_id() { unsigned z = 0u; asm volatile("" : "+v"(z)); return (int)__builtin_amdgcn_mbcnt_hi(~0u, __builtin_amdgcn_mbcnt_lo(~0u, z)); }
__device__ __forceinline__ float shfl_xor_l(float v, int lane, int m) { return __builtin_bit_cast(float, __builtin_amdgcn_ds_bpermute((lane ^ m) << 2, __builtin_bit_cast(int, v))); }
__device__ __forceinline__ void swap32(float v, float& r0, float& r1) { float a = v, b = v;
    asm volatile("s_nop 1\n\tv_permlane32_swap_b32 %0, %1" : "+v"(a), "+v"(b)); r0 = a; r1 = b; }
__device__ __forceinline__ float swap_sum(float v) { float r0, r1; swap32(v, r0, r1); return r0 + r1; }
__device__ __forceinline__ float swap_max(float v) { float r0, r1; swap32(v, r0, r1); return fmaxf(r0, r1); }
__device__ __forceinline__ float partner32(float v, int hi) { float r0, r1; swap32(v, r0, r1); return hi ? r0 : r1; }
template <int CTRL> __device__ __forceinline__ float dpp_mov(float v) { return __builtin_bit_cast(float, __builtin_amdgcn_update_dpp(0, __builtin_bit_cast(int, v), CTRL, 0xf, 0xf, false)); }
__device__ __forceinline__ float wave_sum(float v) {
    v += dpp_mov<0xB1>(v); v += dpp_mov<0x4E>(v); v += dpp_mov<0x141>(v); v += dpp_mov<0x140>(v);
    v = swap_sum(v);
    const int vi = __builtin_bit_cast(int, v);
    return __builtin_bit_cast(float, __builtin_amdgcn_readlane(vi, 0)) + __builtin_bit_cast(float, __builtin_amdgcn_readlane(vi, 16));
}
__device__ __forceinline__ float gelu_tanh(float x) {
    const float u = 0.7978845608028654f * (x + 0.044715f * x * x * x);
    const float e = __expf(2.0f * u);
    return x - x * __builtin_amdgcn_rcpf(e + 1.0f);
}
__device__ __forceinline__ float sigmoidf_(float x) { return __builtin_amdgcn_rcpf(1.0f + __expf(-x)); }
__device__ __forceinline__ float sigmoid_div(float x) { return 1.0f / (1.0f + __expf(-x)); }
__device__ __forceinline__ int crow(int r, int hi) { return (r & 3) + 8 * (r >> 2) + 4 * hi; }

#define XB_TMO      128
#define XB_XCNT(j)  (256  + 64 * (j))
#define XB_XSUB(j)  (1280 + 64 * (j))
#define XB_XGEN(j)  (2304 + 64 * (j))
#define XB_TOP      3328
#define XB_TOPGEN   3392
#define XCD_BAR_WORDS 3456
#define XB_SPIN_CAP (1u << 22)
__device__ __forceinline__ unsigned xb_ld(unsigned* p)              { return __hip_atomic_load(p, __ATOMIC_RELAXED, __HIP_MEMORY_SCOPE_AGENT); }
__device__ __forceinline__ unsigned xb_add(unsigned* p, unsigned v) { return __hip_atomic_fetch_add(p, v, __ATOMIC_RELAXED, __HIP_MEMORY_SCOPE_AGENT); }
__device__ __forceinline__ unsigned xb_xcc_id() { return (unsigned)__builtin_amdgcn_s_getreg((3 << 11) | 20) & 0xFu; }
#define XB_SPIN(cond, bar) do { unsigned _sp = 0; while (cond) { __builtin_amdgcn_s_sleep(1); \
    if ((++_sp & 255u) == 0u) { if (xb_ld(&(bar)[XB_TMO])) break; if (_sp > XB_SPIN_CAP) { atomicAdd(&(bar)[XB_TMO], 1u); break; } } } } while (0)
struct XcdBarrier { unsigned* bar; unsigned x; volatile LAS unsigned* st; int wave; };
__device__ __forceinline__ XcdBarrier xcd_barrier_post(unsigned* bar, volatile LAS unsigned* st) {
    XcdBarrier b; b.bar = bar; b.x = xb_xcc_id(); b.st = st;
    if (threadIdx.x == 0) (void)xb_add(&bar[XB_XCNT(b.x)], 1u);
    b.wave = __builtin_amdgcn_readfirstlane(threadIdx.x >> 6);
    return b;
}
__device__ __forceinline__ void xcd_barrier_complete(unsigned* bar, unsigned x, unsigned& nloc, unsigned& nx) {
    const unsigned G = gridDim.x * gridDim.y * gridDim.z;
    unsigned sum, cnt, mine, sp = 0u;
    for (;;) {
        sum = 0u; cnt = 0u; mine = 0u;
#pragma unroll
        for (unsigned j = 0; j < 16; ++j) { const unsigned c = xb_ld(&bar[XB_XCNT(j)]); sum += c; cnt += (c > 0u) ? 1u : 0u; mine = (j == x) ? c : mine; }
        if (sum == G) break;
        __builtin_amdgcn_s_sleep(1);
        if ((++sp & 255u) == 0u) { if (xb_ld(&bar[XB_TMO])) break; if (sp > XB_SPIN_CAP) { atomicAdd(&bar[XB_TMO], 1u); break; } }
    }
    nloc = mine > 0u ? mine : 1u; nx = cnt > 0u ? cnt : 1u;
}
__device__ __forceinline__ void xcd_barrier(const XcdBarrier& b) {
    asm volatile("s_waitcnt vmcnt(0)" ::: "memory");
    __syncthreads();
    if (b.wave == 0 && lane_id() == 0) {
        unsigned* bar = b.bar; asm volatile("" : "+s"(bar));
        __builtin_amdgcn_s_waitcnt(0);
        unsigned nloc = b.st[0], nx = b.st[1];
        if (nloc == 0u) { xcd_barrier_complete(bar, b.x, nloc, nx); b.st[0] = nloc; b.st[1] = nx; }
        const unsigned old = xb_add(&bar[XB_XSUB(b.x)], 1u);
        const unsigned gen = old / nloc;
        if (old + 1u == (gen + 1u) * nloc) {
            __builtin_amdgcn_fence(__ATOMIC_RELEASE, "agent");
            asm volatile("s_waitcnt vmcnt(0)" ::: "memory");
            const unsigned og = xb_add(&bar[XB_TOP], 1u);
            const unsigned tg = og / nx;
            if (og + 1u == (tg + 1u) * nx) xb_add(&bar[XB_TOPGEN], 1u);
            else XB_SPIN(xb_ld(&bar[XB_TOPGEN]) == tg, bar);
            __builtin_amdgcn_fence(__ATOMIC_ACQUIRE, "agent");
            xb_add(&bar[XB_XGEN(b.x)], 1u);
            asm volatile("s_waitcnt vmcnt(0)" ::: "memory");
        } else {
            XB_SPIN(xb_ld(&bar[XB_XGEN(b.x)]) == gen, bar);
            __builtin_amdgcn_fence(__ATOMIC_ACQUIRE, "agent");
            asm volatile("s_waitcnt vmcnt(0)" ::: "memory");
        }
    }
    __syncthreads();
}

struct Args { const float* in[34]; float* out; unsigned char* ws; int ph_lo, ph_hi; };
struct Frame {
    LAS unsigned char* lds;
    int wave, vcu, G;
};

namespace gm {
constexpr int BM = 256, BK = 64, HALF = 128;
struct Unit { int pm, pn, e; };
struct Gemm { const void* A; const void* Bt; int K; const int* rowidx; size_t b_estride; };
__host__ __device__ __forceinline__ int perm32(int rho) { const int n = rho >> 4, i = rho & 15; return 8 * (i >> 2) + 4 * n + (i & 3); }

struct DenseOrder {
    int nM, nN, nwg, G, c;
    __device__ void init(int M, int N, int G_, int c_) { nM = M / BM; nN = N / BM; nwg = nM * nN; G = G_; c = c_; }
    __device__ bool next(int i, Unit& u) const {
        const long L = (long)i * G + c; if (L >= nwg) return false;
        int wgid = (int)L; { const int q = nwg / 8, r = nwg % 8, xcd = wgid % 8, off = wgid / 8; wgid = (xcd < r ? xcd * (q + 1) : r * (q + 1) + (xcd - r) * q) + off; }
        const int WGM = 8, nig = WGM * nN, gid = wgid / nig, fm = gid * WGM, gsz = (nM - fm) < WGM ? (nM - fm) : WGM;
        u.pm = fm + ((wgid % nig) % gsz); u.pn = (wgid % nig) / gsz; u.e = 0; return true;
    }
};
struct GroupOrder {
    const LAS int* tp; int NT, G, vcu; mutable int ecur;
    __device__ bool next(int i, Unit& u) const {
        const int L = i * G + vcu; const int total = tp[NE1] * NT; if (L >= total) return false;
        const int tile = L / NT; u.pn = L % NT; u.pm = tile;
        int e = ecur;
        while (tile >= tp[e + 1]) ++e;
        ecur = e; u.e = e; return true;
    }
};

constexpr int HTB = HALF * BK * 2, STAGE_BYTES = 8 * HTB;
__host__ __device__ __forceinline__ int lds_byte(int r, int c) { const int st = (r >> 4) * 2 + (c >> 5), rr = r & 15, cc = c & 31, ob = rr * 64 + cc * 2; return st * 1024 + (ob ^ (((ob >> 9) & 1) << 5)); }
__host__ __device__ __forceinline__ void stage_rc(int b, int& R, int& C) { const int st = b / 1024, sb = b % 1024, swz = sb ^ (((sb >> 9) & 1) << 5); R = (st >> 1) * 16 + swz / 64; C = (st & 1) * 32 + (swz % 64) / 2; }

template <class Epi, class Sched, bool GATHER, bool FP8 = false, bool ALIGN = true>
__device__ __forceinline__ void gemm_phase(LAS unsigned char* lds, int wave, const Gemm g, const Sched& S, const Epi& E) {
    int lane = lane_id(); asm volatile("" : "+v"(lane));
    const int wid = wave, tid = wid * 64 + lane, wr = wid >> 2, wc = wid & 3, fr = lane & 15, fq = lane >> 4;
    const int K = g.K * (FP8 ? 1 : 2), nt = K / 128;
    int Rr[2], Cc[2]; unsigned voffB0[2], voffB1[2];
#pragma unroll
    for (int i = 0; i < 2; ++i) { int R, C; stage_rc(tid * 16 + i * 8192, R, C); Rr[i] = R; Cc[i] = 2 * C;
        int r0, r1;
        if constexpr (Epi::WIDE) { const int rho = R & 31, q = 16 * ((rho & 15) >> 2) + 4 * (rho >> 4) + (rho & 3); r0 = 64 * (R >> 5) + q; r1 = r0 + 8; }
        else { const int Rb = Epi::PERM ? ((R & ~31) + perm32(R & 31)) : R; r0 = Rb; r1 = HALF + Rb; }
        voffB0[i] = (unsigned)(r0 * K + 2 * C); voffB1[i] = (unsigned)(r1 * K + 2 * C); }
    const size_t kstep = 128, hstep = (size_t)HALF * K, tstep = 2 * hstep;
    const unsigned ldsw = (unsigned)wid * 1024u;
    const int aoff = lds_byte(wr * 64 + fr, fq * 8), boff = lds_byte(wc * 32 + fr, fq * 8);
    constexpr int KOFF = 1024;
#define PG8_SA(b, h) (((b) * 2 + (h)) * HTB)
#define PG8_SB(b, h) ((4 + (b) * 2 + (h)) * HTB)
#define PG8_STAGE(bufoff, gbase, voff) do { _Pragma("unroll") for (int _i = 0; _i < 2; ++_i) \
        __builtin_amdgcn_global_load_lds((const unsigned*)((const char*)(gbase) + (voff)[_i]), (LAS unsigned*)(lds + (bufoff) + ldsw + _i * 8192), 16, 0, 0); } while (0)
#define PG8_LDA(dst, b, h) do { _Pragma("unroll") for (int m = 0; m < 4; ++m) _Pragma("unroll") for (int k = 0; k < 2; ++k) dst[m][k] = *(const LAS bf16x8*)(lds + PG8_SA(b, h) + aoff + m * 2048 + k * KOFF); } while (0)
#define PG8_LDB(dst, b, h) do { _Pragma("unroll") for (int n = 0; n < 2; ++n) _Pragma("unroll") for (int k = 0; k < 2; ++k) dst[n][k] = *(const LAS bf16x8*)(lds + PG8_SB(b, h) + boff + n * 2048 + k * KOFF); } while (0)
#define PG8_CAT(x) __builtin_bit_cast(v8i_t, __builtin_shufflevector((x)[0], (x)[1], 0, 1, 2, 3, 4, 5, 6, 7, 8, 9, 10, 11, 12, 13, 14, 15))
#define PG8_MMA(ai, bj, At, Bt) do { __builtin_amdgcn_s_setprio(1); _Pragma("unroll") for (int m = 0; m < 4; ++m) _Pragma("unroll") for (int n = 0; n < 2; ++n) { \
        if constexpr (FP8) acc[ai][bj][m][n] = __builtin_amdgcn_mfma_scale_f32_16x16x128_f8f6f4(PG8_CAT(Bt[n]), PG8_CAT(At[m]), acc[ai][bj][m][n], 0, 0, 0, 0x7F7F7F7F, 0, 0x7F7F7F7F); \
        else { _Pragma("unroll") for (int k = 0; k < 2; ++k) acc[ai][bj][m][n] = __builtin_amdgcn_mfma_f32_16x16x32_bf16(Bt[n][k], At[m][k], acc[ai][bj][m][n], 0, 0, 0); } } \
        __builtin_amdgcn_s_setprio(0); } while (0)
#define PG8_WAIT_V(n) asm volatile("s_waitcnt vmcnt(" #n ")" ::: "memory")
#define PG8_WAIT_L(n) asm volatile("s_waitcnt lgkmcnt(" #n ")" ::: "memory")
#define PG8_BAR __builtin_amdgcn_s_barrier()
#define PG8_SCHED __builtin_amdgcn_sched_barrier(0)
#define PG8_AOFF(u_, o0, o1) do { _Pragma("unroll") for (int _i = 0; _i < 2; ++_i) { const int r0 = (u_).pm * BM + Rr[_i], r1 = r0 + HALF; \
        const int g0 = GATHER ? g.rowidx[r0] : r0, g1 = GATHER ? g.rowidx[r1] : r1; \
        o0[_i] = (unsigned)g0 * (unsigned)K + (unsigned)Cc[_i]; o1[_i] = (unsigned)g1 * (unsigned)K + (unsigned)Cc[_i]; } } while (0)
    Unit cur, nxt; int ui = 0;
    if (!S.next(0, cur)) return;
    f32x4 acc[2][2][4][2];
#pragma unroll
    for (int a = 0; a < 2; ++a)
#pragma unroll
        for (int b = 0; b < 2; ++b)
#pragma unroll
            for (int m = 0; m < 4; ++m)
#pragma unroll
                for (int n = 0; n < 2; ++n) acc[a][b][m][n] = (f32x4){0.f, 0.f, 0.f, 0.f};
    bf16x8 At[4][2], B0[2][2], B1[2][2];
    unsigned ca0[2], ca1[2];
    PG8_AOFF(cur, ca0, ca1);
    const char* Ab = (const char*)g.A;
    const char* cB = (const char*)g.Bt + (size_t)cur.e * g.b_estride + (size_t)cur.pn * tstep;
    PG8_STAGE(PG8_SB(0, 0), cB, voffB0); PG8_STAGE(PG8_SB(0, 1), cB, voffB1); PG8_STAGE(PG8_SA(0, 0), Ab, ca0); PG8_STAGE(PG8_SA(0, 1), Ab, ca1);
    if (wr == 1) PG8_BAR;
    PG8_WAIT_V(2); PG8_BAR;
    PG8_STAGE(PG8_SB(1, 0), cB + kstep, voffB0); PG8_STAGE(PG8_SA(1, 0), Ab + kstep, ca0); PG8_STAGE(PG8_SB(1, 1), cB + kstep, voffB1);
    PG8_WAIT_V(6); PG8_BAR;
    for (;;) {
        const bool has_next = S.next(ui + 1, nxt);
        const char* nB = has_next ? (const char*)g.Bt + (size_t)nxt.e * g.b_estride + (size_t)nxt.pn * tstep : cB;
#pragma unroll 1
        for (int t = 0; t < nt; t += 2) {
            const bool last = (t == nt - 2);
            const char* a1 = Ab + (size_t)(t + 1) * kstep;
            const char* a2 = last ? Ab : Ab + (size_t)(t + 2) * kstep; const char* b2 = last ? nB : cB + (size_t)(t + 2) * kstep;
            const char* a3 = a2 + kstep; const char* b3 = b2 + kstep;
            PG8_LDB(B0, 0, 0); PG8_LDB(B1, 0, 1); PG8_SCHED; PG8_LDA(At, 0, 0); PG8_STAGE(PG8_SA(1, 1), a1, ca1);
            if (last && has_next) PG8_AOFF(nxt, ca0, ca1);
            PG8_WAIT_V(8); PG8_WAIT_L(0); PG8_BAR; PG8_MMA(0, 0, At, B0); PG8_MMA(0, 1, At, B1); PG8_BAR; PG8_SCHED;
            PG8_LDA(At, 0, 1); PG8_STAGE(PG8_SB(0, 0), b2, voffB0); PG8_STAGE(PG8_SB(0, 1), b2, voffB1); PG8_STAGE(PG8_SA(0, 0), a2, ca0);
            PG8_WAIT_V(8); PG8_WAIT_L(0); PG8_BAR; PG8_MMA(1, 0, At, B0); PG8_MMA(1, 1, At, B1); PG8_BAR; PG8_SCHED;
            PG8_LDB(B0, 1, 0); PG8_LDB(B1, 1, 1); PG8_SCHED; PG8_LDA(At, 1, 0); PG8_STAGE(PG8_SA(0, 1), a2, ca1);
            PG8_WAIT_V(8); PG8_WAIT_L(0); PG8_BAR; PG8_MMA(0, 0, At, B0); PG8_MMA(0, 1, At, B1); PG8_BAR; PG8_SCHED;
            PG8_LDA(At, 1, 1); PG8_STAGE(PG8_SB(1, 0), b3, voffB0); PG8_STAGE(PG8_SB(1, 1), b3, voffB1); PG8_STAGE(PG8_SA(1, 0), a3, ca0);
            PG8_WAIT_V(8); PG8_WAIT_L(0); PG8_BAR; PG8_MMA(1, 0, At, B0); PG8_MMA(1, 1, At, B1); PG8_BAR; PG8_SCHED;
        }
        if constexpr (ALIGN) { if (wr == 0) PG8_BAR; }
        E(acc, cur, wr, wc, fr, fq);
        if (!has_next) break;
#pragma unroll
        for (int a = 0; a < 2; ++a)
#pragma unroll
            for (int b = 0; b < 2; ++b)
#pragma unroll
                for (int m = 0; m < 4; ++m)
#pragma unroll
                    for (int n = 0; n < 2; ++n) acc[a][b][m][n] = (f32x4){0.f, 0.f, 0.f, 0.f};
        cur = nxt; cB = nB; ++ui;
        if constexpr (ALIGN) { if (wr == 1) PG8_BAR; }
    }
    PG8_WAIT_V(0);
    if constexpr (!ALIGN) { if (wr == 0) PG8_BAR; }
    PG8_BAR;
#undef PG8_SA
#undef PG8_SB
#undef PG8_STAGE
#undef PG8_LDA
#undef PG8_LDB
#undef PG8_MMA
#undef PG8_CAT
#undef PG8_WAIT_V
#undef PG8_WAIT_L
#undef PG8_BAR
#undef PG8_SCHED
#undef PG8_AOFF
}

__device__ __forceinline__ unsigned cvt_pk_bf16(float lo, float hi) { typedef __bf16 bf16x2_t __attribute__((ext_vector_type(2))); f32x2 v = {lo, hi}; bf16x2_t b = __builtin_convertvector(v, bf16x2_t); return __builtin_bit_cast(unsigned, b); }

template <bool FP8OUT> struct EpiStore {
    static constexpr bool PERM = true, WIDE = true;
    void* O; int ldc; float scale;
    __device__ __forceinline__ void operator()(const f32x4 (&acc)[2][2][4][2], const Unit& u, int wr, int wc, int fr, int fq) const {
        const int row0 = u.pm * BM + wr * 64 + fr, col0 = u.pn * BM + wc * 64 + 16 * fq;
#pragma unroll
        for (int ai = 0; ai < 2; ++ai)
#pragma unroll
            for (int m = 0; m < 4; ++m) { const size_t off = (size_t)(row0 + ai * HALF + m * 16) * ldc + col0;
                const f32x4 v0 = acc[ai][0][m][0] * scale, v1 = acc[ai][0][m][1] * scale, v2 = acc[ai][1][m][0] * scale, v3 = acc[ai][1][m][1] * scale;
                if constexpr (FP8OUT) { u32x4 w; w.x = pk4_fp8(v0[0], v0[1], v0[2], v0[3]); w.y = pk4_fp8(v1[0], v1[1], v1[2], v1[3]); w.z = pk4_fp8(v2[0], v2[1], v2[2], v2[3]); w.w = pk4_fp8(v3[0], v3[1], v3[2], v3[3]);
                    *(u32x4*)((unsigned char*)O + off) = w; }
                else { u32x4 wa, wb; wa.x = cvt_pk_bf16(v0[0], v0[1]); wa.y = cvt_pk_bf16(v0[2], v0[3]); wa.z = cvt_pk_bf16(v1[0], v1[1]); wa.w = cvt_pk_bf16(v1[2], v1[3]);
                    wb.x = cvt_pk_bf16(v2[0], v2[1]); wb.y = cvt_pk_bf16(v2[2], v2[3]); wb.z = cvt_pk_bf16(v3[0], v3[1]); wb.w = cvt_pk_bf16(v3[2], v3[3]);
                    *(u32x4*)((bf16*)O + off) = wa; *(u32x4*)((bf16*)O + off + 8) = wb; } }
    }
};
typedef EpiStore<false> EpiBf16;
struct EpiResBf16 {
    static constexpr bool PERM = true, WIDE = true;
    bf16* O; const bf16* R; int ldc; float alpha;
    __device__ __forceinline__ void operator()(const f32x4 (&acc)[2][2][4][2], const Unit& u, int wr, int wc, int fr, int fq) const {
        const int row0 = u.pm * BM + wr * 64 + fr, col0 = u.pn * BM + wc * 64 + 16 * fq;
#pragma unroll
        for (int ai = 0; ai < 2; ++ai)
#pragma unroll
            for (int m = 0; m < 4; ++m) { const size_t off = (size_t)(row0 + ai * HALF + m * 16) * ldc + col0;
                const u32x4 ra = *(const u32x4*)(R + off), rb = *(const u32x4*)(R + off + 8);
                const f32x4 v0 = acc[ai][0][m][0], v1 = acc[ai][0][m][1], v2 = acc[ai][1][m][0], v3 = acc[ai][1][m][1];
                u32x4 wa, wb;
                wa.x = cvt_pk_bf16(bflo(ra.x) * alpha + v0[0], bfhi(ra.x) * alpha + v0[1]); wa.y = cvt_pk_bf16(bflo(ra.y) * alpha + v0[2], bfhi(ra.y) * alpha + v0[3]);
                wa.z = cvt_pk_bf16(bflo(ra.z) * alpha + v1[0], bfhi(ra.z) * alpha + v1[1]); wa.w = cvt_pk_bf16(bflo(ra.w) * alpha + v1[2], bfhi(ra.w) * alpha + v1[3]);
                wb.x = cvt_pk_bf16(bflo(rb.x) * alpha + v2[0], bfhi(rb.x) * alpha + v2[1]); wb.y = cvt_pk_bf16(bflo(rb.y) * alpha + v2[2], bfhi(rb.y) * alpha + v2[3]);
                wb.z = cvt_pk_bf16(bflo(rb.z) * alpha + v3[0], bfhi(rb.z) * alpha + v3[1]); wb.w = cvt_pk_bf16(bflo(rb.w) * alpha + v3[2], bfhi(rb.w) * alpha + v3[3]);
                *(u32x4*)(O + off) = wa; *(u32x4*)(O + off + 8) = wb; }
    }
};
struct EpiResF32 {
    static constexpr bool PERM = false, WIDE = false;
    float* C; const float* R; int ldc; float alpha;
    __device__ __forceinline__ void operator()(const f32x4 (&acc)[2][2][4][2], const Unit& u, int wr, int wc, int fr, int fq) const {
        const int row0 = u.pm * BM + wr * 64 + fr, col0 = u.pn * BM + wc * 32 + 4 * fq;
#pragma unroll
        for (int ai = 0; ai < 2; ++ai)
#pragma unroll
            for (int m = 0; m < 4; ++m) { const size_t off = (size_t)(row0 + ai * HALF + m * 16) * ldc + col0;
#pragma unroll
                for (int bj = 0; bj < 2; ++bj)
#pragma unroll
                    for (int n = 0; n < 2; ++n) { const f32x4 r = *(const f32x4*)(R + off + bj * HALF + n * 16); *(f32x4*)(C + off + bj * HALF + n * 16) = r * alpha + acc[ai][bj][m][n]; } }
    }
};
template <bool FP8OUT> struct EpiSwiGlu {
    static constexpr bool PERM = true, WIDE = false;
    void* H; float isc;
    __device__ __forceinline__ void operator()(const f32x4 (&acc)[2][2][4][2], const Unit& u, int wr, int wc, int fr, int fq) const {
        const int row0 = u.pm * BM + wr * 64 + fr, col0 = u.pn * HALF + wc * 32 + 8 * fq;
#pragma unroll
        for (int ai = 0; ai < 2; ++ai)
#pragma unroll
            for (int m = 0; m < 4; ++m) { const size_t off = (size_t)(row0 + ai * HALF + m * 16) * DEXP + col0;
                float hv[8];
#pragma unroll
                for (int n = 0; n < 2; ++n)
#pragma unroll
                    for (int j = 0; j < 4; ++j) { const float gg = acc[ai][0][m][n][j] * isc, uu = acc[ai][1][m][n][j] * isc; hv[4 * n + j] = gg * sigmoidf_(gg) * uu; }
                if constexpr (FP8OUT) { u32x2 w; w.x = pk4_fp8(hv[0], hv[1], hv[2], hv[3]); w.y = pk4_fp8(hv[4], hv[5], hv[6], hv[7]); __builtin_nontemporal_store(w, (u32x2*)((unsigned char*)H + off)); }
                else { u32x4 w; w.x = cvt_pk_bf16(hv[0], hv[1]); w.y = cvt_pk_bf16(hv[2], hv[3]); w.z = cvt_pk_bf16(hv[4], hv[5]); w.w = cvt_pk_bf16(hv[6], hv[7]); __builtin_nontemporal_store(w, (u32x4*)((bf16*)H + off)); } }
    }
};
}

struct TItem { const float* src; bf16* dst; int K, N, k0, n0, drow0; float scale; int fp8; };
constexpr int TI_WIN = (D / 64) * (PW / 64), TI_WOUT = (D / 64) * (D / 64), TI_WGLU = (GW / 64) * (GW / 64), TI_GU1 = (D / 64) * (1024 / 64), TI_DN1 = (DEXP / 64) * (D / 64);
constexpr int TI_LAYER = TI_WIN + TI_WOUT + TI_WGLU + NE1 * TI_GU1 + NE1 * TI_DN1, TI_TOTAL = DEPTH * TI_LAYER;
template <class KA>
__device__ __forceinline__ TItem decode_titem(KA ap, unsigned char* ws, int it) {
    TItem t; const int l = it / TI_LAYER; int r = it % TI_LAYER; t.scale = 1.f; t.fp8 = 0;
    if (r < TI_WIN) { const int nnb = PW / 64; t.K = D; t.N = PW; t.k0 = (r / nnb) * 64; t.n0 = (r % nnb) * 64; t.drow0 = t.n0; t.src = ap->in[1] + (size_t)l * D * PW; t.dst = (bf16*)(ws + WS_WIN) + (size_t)l * PW * D;
        t.scale = (t.n0 >= C_Q && t.n0 < C_K) ? QSCALE : 1.f; return t; }
    r -= TI_WIN;
    if (r < TI_WOUT) { const int nnb = D / 64; t.K = D; t.N = D; t.k0 = (r / nnb) * 64; t.n0 = (r % nnb) * 64; t.drow0 = t.n0; t.src = ap->in[2] + (size_t)l * D * D; t.dst = (bf16*)(ws + WS_WOUT) + (size_t)l * D * D; return t; }
    r -= TI_WOUT;
    if (r < TI_WGLU) { const int nnb = GW / 64; t.K = GW; t.N = GW; t.k0 = (r / nnb) * 64; t.n0 = (r % nnb) * 64; t.drow0 = t.n0; t.src = ap->in[12] + (size_t)l * GW * GW; t.dst = (bf16*)(ws + WS_WGLU) + (size_t)l * GW * GW; return t; }
    r -= TI_WGLU;
    if (r < NE1 * TI_GU1) { const int e = r / TI_GU1, q = r % TI_GU1, nnb = 1024 / 64; t.K = D; t.N = 1024; t.k0 = (q / nnb) * 64; t.n0 = (q % nnb) * 64;
        { const int half = t.n0 / 512, j = t.n0 % 512; t.drow0 = 256 * (j / 128) + 128 * half + (j % 128); }
        t.src = (e < NEXP) ? ap->in[28] + ((size_t)l * NEXP + e) * D * 1024 : ap->in[30] + (size_t)l * D * 1024; t.dst = (bf16*)(ws + WS_WGU) + ((size_t)l * NE1 + e) * 1024 * D;
        if (l >= FP8_FIRST) { t.fp8 = 1; t.scale = W8SCALE; t.dst = (bf16*)(ws + WS_WGU + (size_t)l * NE1 * 1024 * D * 2 + (size_t)e * 1024 * D); }
        return t; }
    r -= NE1 * TI_GU1;
    { const int e = r / TI_DN1, q = r % TI_DN1, nnb = D / 64; t.K = DEXP; t.N = D; t.k0 = (q / nnb) * 64; t.n0 = (q % nnb) * 64; t.drow0 = t.n0;
      t.src = (e < NEXP) ? ap->in[29] + ((size_t)l * NEXP + e) * DEXP * D : ap->in[31] + (size_t)l * DEXP * D; t.dst = (bf16*)(ws + WS_WDN) + ((size_t)l * NE1 + e) * D * DEXP;
      if (DOWN_FP8 && l >= FP8_FIRST) { t.fp8 = 1; t.scale = W8SCALE; t.dst = (bf16*)(ws + WS_WDN + (size_t)l * NE1 * D * DEXP * 2 + (size_t)e * D * DEXP); }
      return t; }
}
__device__ __forceinline__ void titem_load(const TItem& t, f32x4 (&v)[16], int lane) {
    const float* p = t.src + (size_t)(t.k0 + (lane >> 4)) * t.N + t.n0 + (lane & 15) * 4;
#pragma unroll
    for (int i = 0; i < 16; ++i) v[i] = __builtin_nontemporal_load((const f32x4*)(p + (size_t)(4 * i) * t.N));
}
__device__ __forceinline__ void titem_to_lds(const f32x4 (&v)[16], LAS float* scr, int lane) {
    LAS float* q = scr + (lane >> 4) * 65 + (lane & 15) * 4;
#pragma unroll
    for (int i = 0; i < 16; ++i) { q[(4 * i) * 65] = v[i].x; q[(4 * i) * 65 + 1] = v[i].y; q[(4 * i) * 65 + 2] = v[i].z; q[(4 * i) * 65 + 3] = v[i].w; }
}
__device__ __forceinline__ void titem_store(const TItem& t, const LAS float* scr, int lane) {
    if (t.fp8) {
        const int c = lane & 3; const float sc = t.scale; unsigned char* d8 = (unsigned char*)t.dst;
#pragma unroll
        for (int j = 0; j < 4; ++j) { const int n = 16 * j + (lane >> 2); const LAS float* s = scr + (16 * c) * 65 + n;
            u32x4 o; o.x = pk4_fp8(s[0] * sc, s[65] * sc, s[2 * 65] * sc, s[3 * 65] * sc); o.y = pk4_fp8(s[4 * 65] * sc, s[5 * 65] * sc, s[6 * 65] * sc, s[7 * 65] * sc);
            o.z = pk4_fp8(s[8 * 65] * sc, s[9 * 65] * sc, s[10 * 65] * sc, s[11 * 65] * sc); o.w = pk4_fp8(s[12 * 65] * sc, s[13 * 65] * sc, s[14 * 65] * sc, s[15 * 65] * sc);
            __builtin_nontemporal_store(o, (u32x4*)(d8 + (size_t)(t.drow0 + n) * t.K + t.k0 + 16 * c)); }
        return; }
    const int c = lane & 7; const float sc = t.scale;
#pragma unroll
    for (int j = 0; j < 8; ++j) { const int n = 8 * j + (lane >> 3); const LAS float* s = scr + (8 * c) * 65 + n;
        u32x4 o; o.x = pk2(s[0] * sc, s[65] * sc); o.y = pk2(s[2 * 65] * sc, s[3 * 65] * sc); o.z = pk2(s[4 * 65] * sc, s[5 * 65] * sc); o.w = pk2(s[6 * 65] * sc, s[7 * 65] * sc);
        __builtin_nontemporal_store(o, (u32x4*)(t.dst + (size_t)(t.drow0 + n) * t.K + t.k0 + 8 * c)); }
}
constexpr int TI_DEFER = 8192;
static_assert(TI_DEFER <= NE1 * TI_DN1, "deferred items must be last-layer down weights");
__device__ __forceinline__ void convert_items(const Frame& F, int first, int last, int rank, int nranks) {
    typedef const __attribute__((address_space(4))) Args* KArgs; KArgs ap = (KArgs)__builtin_amdgcn_kernarg_segment_ptr(); asm volatile("" : "+s"(ap));
    unsigned char* ws = ap->ws;
    int lane = lane_id(); asm volatile("" : "+v"(lane));
    LAS float* scr = (LAS float*)(F.lds + F.wave * 16640);
    f32x4 v[16]; int it = first + rank;
    TItem cur = decode_titem(ap, ws, it < last ? it : 0);
    if (it < last) titem_load(cur, v, lane);
    while (it < last) {
        titem_to_lds(v, scr, lane);
        const int nx = it + nranks; const TItem nxt = decode_titem(ap, ws, nx < last ? nx : 0);
        if (nx < last) titem_load(nxt, v, lane);
        asm volatile("s_waitcnt lgkmcnt(0)" ::: "memory");
        titem_store(cur, scr, lane);
        asm volatile("s_waitcnt lgkmcnt(0)" ::: "memory");
        cur = nxt; it = nx;
    }
}
__device__ __forceinline__ void p0_prologue(const Frame& F, const Args& a_) {
    typedef const __attribute__((address_space(4))) Args* KArgs; KArgs ap = (KArgs)__builtin_amdgcn_kernarg_segment_ptr(); asm volatile("" : "+s"(ap));
#define a (*ap)
    unsigned char* ws = a.ws;
    int lane = lane_id(); asm volatile("" : "+v"(lane));
    LAS float* scr = (LAS float*)(F.lds + F.wave * 16640);
    const int gw = F.vcu * NWAVES + F.wave, NGW = F.G * NWAVES;
    const int gt = gw * 64 + lane, NGT = NGW * 64;
    { const f32x4* x4 = (const f32x4*)a.in[0]; u32x2* o = (u32x2*)(ws + WS_XB);
      for (size_t i = gt; i < (size_t)T * D / 4; i += NGT) { const f32x4 v = x4[i]; u32x2 w; w.x = pk2(v.x, v.y); w.y = pk2(v.z, v.w); o[i] = w; } }
    for (int l = 0; l < DEPTH; ++l) {
        {
            unsigned char* tab = ws + WS_S5TAB + (size_t)l * S5TAB_STRIDE;
            const float* lre = a.in[4] + l * 2048; const float* lim = a.in[5] + l * 2048; const float* ldt = a.in[6] + l * 32;
            const float* bre = a.in[7] + (size_t)l * 32768; const float* bim = a.in[8] + (size_t)l * 32768;
            const float* cre = a.in[9] + (size_t)l * 32768; const float* cim = a.in[10] + (size_t)l * 32768;
            for (int i = gt; i < 2048; i += NGT) {
                const int g = i >> 6; const float dt = expf(ldt[g]); const float ar = lre[i], ai = lim[i];
                const float er = expf(ar * dt); const float sn = sinf(ai * dt), cs = cosf(ai * dt);
                const float abr = er * cs, abi = er * sn;
                ((f32x2*)(tab + S5T_ABAR))[i] = (f32x2){abr, abi};
                const float eL = expf(ar * dt * 64.0f); const float snL = sinf(ai * dt * 64.0f), csL = cosf(ai * dt * 64.0f);
                ((f32x2*)(tab + S5T_AL))[i] = (f32x2){eL * csL, eL * snL};
                const float nr = abr - 1.0f, ni = abi, den = ar * ar + ai * ai;
                const float cr = (nr * ar + ni * ai) / den, ci = (ni * ar - nr * ai) / den;
                bf16* bm = (bf16*)(tab + S5T_BMAT) + (size_t)g * 128 * 16; const int p = i & 63;
#pragma unroll 4
                for (int h = 0; h < 16; ++h) { const float br = bre[(size_t)i * 16 + h], bi = bim[(size_t)i * 16 + h];
                    bm[p * 16 + h] = (bf16)f2bf(cr * br - ci * bi); bm[(64 + p) * 16 + h] = (bf16)f2bf(cr * bi + ci * br); }
            }
            const float* dd = a.in[11] + l * GW;
            for (int i = gt; i < 32 * 32 * CM_PITCH; i += NGT) {
                const int g = i / (32 * CM_PITCH), hh = (i / CM_PITCH) & 31, k = i % CM_PITCH; float v = 0.f;
                if (hh < 16) { if (k < 64) v = cre[((size_t)g * 16 + hh) * 64 + k]; else if (k < 128) v = -cim[((size_t)g * 16 + hh) * 64 + (k - 64)]; else v = (k - 128 == hh) ? dd[16 * g + hh] : 0.f; }
                ((bf16*)(tab + S5T_CMAT))[i] = (bf16)f2bf(v);
            }
        }
        { const float* sw = a.in[16] + (size_t)l * 65536; bf16* o = (bf16*)(ws + WS_SGUW) + (size_t)l * 65536;
          for (int i = gt; i < 65536; i += NGT) o[i] = (bf16)f2bf(sw[i]); }
        {
            const float* rw = a.in[26] + (size_t)l * D * NEXP; bf16* hi = (bf16*)(ws + WS_RT) + (size_t)l * 2 * NEXP * D; bf16* lo = hi + (size_t)NEXP * D;
            for (int i = gt; i < NEXP * D; i += NGT) { const int e = i / D, k = i % D; const float v = rw[(size_t)k * NEXP + e]; const unsigned h = f2bf(v); hi[i] = (bf16)h; lo[i] = (bf16)f2bf(v - bf2f(h)); }
        }
    }
    if (F.G == 256) convert_items(F, 0, TI_WIN, gw, NGW); else convert_items(F, 0, TI_TOTAL - TI_DEFER, gw, NGW);
#undef a
}

namespace at {
constexpr int STAGE = 32768, LDS_LUT = 2 * STAGE, LDS_ATT_BYTES = LDS_LUT + 1024;
__device__ __forceinline__ int t5_bucket(int rel) {
    const int ret = rel > 0 ? 16 : 0; const int n = rel < 0 ? -rel : rel;
    int b;
    if (n < 8) b = n; else if (n < 12) b = 8; else if (n < 16) b = 9; else if (n < 23) b = 10; else if (n < 32) b = 11; else if (n < 46) b = 12; else if (n < 64) b = 13; else if (n < 91) b = 14; else b = 15;
    return ret + b;
}
__device__ __forceinline__ s16x4 vtr(const LAS unsigned char* p) { typedef short v4i16_t __attribute__((ext_vector_type(4))); return __builtin_bit_cast(s16x4, __builtin_amdgcn_ds_read_tr16_b64_v4i16((LAS v4i16_t*)p)); }

__device__ __forceinline__ void attn_unit(const Frame& F, const bf16* __restrict__ proj, bf16* mix, const float* relb, const float* subg, int h, int qb, float lam, float one_m_li) {
    LAS unsigned char* lds = F.lds;
    int tid = F.wave * 64 + lane_id(); asm volatile("" : "+v"(tid));
    const int lane = tid & 63, w = F.wave, r32 = lane & 31, hi = lane >> 5, m = w >> 2, wq = w & 3;
    const int q0 = qb * 128, qrow = q0 + 32 * wq + r32, cw = (q0 + 32 * wq) >> 6, NT = 2 * qb + 2;
    LAS float* lut = (LAS float*)(lds + LDS_LUT);
    if (tid < 256) { const int rel = tid - 192; lut[tid] = (relb[t5_bucket(rel) * 4 + h] - relb[15 * 4 + h]) * LOG2E; }
    bf16x8 qr[4];
#pragma unroll
    for (int d0 = 0; d0 < 4; ++d0) qr[d0] = *(const bf16x8*)(proj + (size_t)qrow * PW + C_Q + h * 128 + m * 64 + 16 * d0 + 8 * hi);
    u32x4 rk[2], rv[2];
    const bf16* kbase = proj + C_K + h * 128; const bf16* vbase = proj + C_V + h * 128;
#define AT_LOAD(j) do { _Pragma("unroll") for (int i = 0; i < 2; ++i) { const int id = tid + 512 * i, row = id >> 4, c16 = id & 15; \
        rk[i] = *(const u32x4*)(kbase + (size_t)(64 * (j) + row) * PW + c16 * 8); rv[i] = *(const u32x4*)(vbase + (size_t)(64 * (j) + row) * PW + c16 * 8); } } while (0)
#define AT_STORE(buf) do { _Pragma("unroll") for (int i = 0; i < 2; ++i) { const int id = tid + 512 * i, row = id >> 4, c16 = id & 15, mk = c16 >> 3, c = c16 & 7; \
        *(LAS u32x4*)(lds + (buf) * STAGE + mk * 8192 + c * 1024 + ((row ^ c) * 16)) = rk[i]; \
        *(LAS u32x4*)(lds + (buf) * STAGE + 16384 + (c16 >> 2) * 4096 + row * 64 + (c16 & 3) * 16) = rv[i]; } } while (0)
    AT_LOAD(0);
    __syncthreads();
    AT_STORE(0);
    AT_LOAD(1);
    __syncthreads();
    float mrun = 0.f, lsum = 0.f;
    f32x16 negm = (f32x16){};
    f32x16 o[4];
#pragma unroll
    for (int eb = 0; eb < 4; ++eb) o[eb] = (f32x16){};
    for (int j = 0; j < NT; ++j) {
        const int cur = j & 1;
        bf16x8 kf[2][2];
        const LAS unsigned char* Kb = lds + cur * STAGE + m * 8192;
        if (j <= cw) {
#pragma unroll
            for (int d0 = 0; d0 < 2; ++d0) { const int c = 2 * d0 + hi; kf[d0][0] = *(const LAS bf16x8*)(Kb + c * 1024 + ((r32 ^ c) * 16)); kf[d0][1] = *(const LAS bf16x8*)(Kb + c * 1024 + ((r32 ^ c) * 16) + 512); } }
        __builtin_amdgcn_sched_barrier(0);
        if (j + 1 < NT) AT_STORE(cur ^ 1);
        if (j + 2 < NT) AT_LOAD(j + 2);
        if (j <= cw) {
            f32x16 p0, p1;
#pragma unroll
            for (int d0 = 0; d0 < 4; ++d0) { const int c = 2 * d0 + hi;
                const bf16x8 a0 = (d0 < 2) ? kf[d0 & 1][0] : *(const LAS bf16x8*)(Kb + c * 1024 + ((r32 ^ c) * 16));
                const bf16x8 a1 = (d0 < 2) ? kf[d0 & 1][1] : *(const LAS bf16x8*)(Kb + c * 1024 + ((r32 ^ c) * 16) + 512);
                if (d0 == 0) { p0 = __builtin_amdgcn_mfma_f32_32x32x16_bf16(a0, qr[0], negm, 0, 0, 0); p1 = __builtin_amdgcn_mfma_f32_32x32x16_bf16(a1, qr[0], negm, 0, 0, 0); }
                else { p0 = __builtin_amdgcn_mfma_f32_32x32x16_bf16(a0, qr[d0], p0, 0, 0, 0); p1 = __builtin_amdgcn_mfma_f32_32x32x16_bf16(a1, qr[d0], p1, 0, 0, 0); } }
            if (j >= cw - 2) {
                const int base = 64 * j - qrow + 192;
#pragma unroll
                for (int r = 0; r < 16; ++r) { const int kv = crow(r, hi); p0[r] += lut[base + kv]; p1[r] += lut[base + kv + 32]; }
            }
            float mx = fmaxf(fmaxf(p0[0], p0[1]), p1[0]), mb = fmaxf(fmaxf(p0[2], p0[3]), p1[1]); mx = fmaxf(fmaxf(mx, p1[2]), p1[3]);
#pragma unroll
            for (int r = 4; r < 16; r += 4) { mx = fmaxf(fmaxf(mx, p0[r]), p0[r + 1]); mb = fmaxf(fmaxf(mb, p0[r + 2]), p0[r + 3]); mx = fmaxf(fmaxf(mx, p1[r]), p1[r + 1]); mb = fmaxf(fmaxf(mb, p1[r + 2]), p1[r + 3]); }
            mx = swap_max(fmaxf(mx, mb));
            if (j == 0 || __any(mx > 8.0f)) {
                const float dl = (j == 0) ? mx : fmaxf(mx, 0.f); mrun += dl;
                const float alpha = __builtin_amdgcn_exp2f(-dl); lsum *= alpha;
#pragma unroll
                for (int r = 0; r < 16; ++r) { p0[r] -= dl; p1[r] -= dl; negm[r] = -mrun; }
#pragma unroll
                for (int eb = 0; eb < 4; ++eb)
#pragma unroll
                    for (int r = 0; r < 16; ++r) o[eb][r] *= alpha;
            }
            bf16x8 pb[4]; float lpart[4];
#define AT_EXPBLK(s_) do { float sm_ = 0.f; u32x4 wv_; \
            if ((s_) < 2) { _Pragma("unroll") for (int i_ = 0; i_ < 8; ++i_) { p0[8 * (s_) + i_] = __builtin_amdgcn_exp2f(p0[8 * (s_) + i_]); } \
                sm_ = ((p0[8 * (s_) + 0] + p0[8 * (s_) + 1]) + (p0[8 * (s_) + 2] + p0[8 * (s_) + 3])) + ((p0[8 * (s_) + 4] + p0[8 * (s_) + 5]) + (p0[8 * (s_) + 6] + p0[8 * (s_) + 7])); \
                wv_.x = gm::cvt_pk_bf16(p0[8 * (s_) + 0], p0[8 * (s_) + 1]); wv_.y = gm::cvt_pk_bf16(p0[8 * (s_) + 2], p0[8 * (s_) + 3]); wv_.z = gm::cvt_pk_bf16(p0[8 * (s_) + 4], p0[8 * (s_) + 5]); wv_.w = gm::cvt_pk_bf16(p0[8 * (s_) + 6], p0[8 * (s_) + 7]); } \
            else { constexpr int b_ = 8 * ((s_) & 1); _Pragma("unroll") for (int i_ = 0; i_ < 8; ++i_) { p1[b_ + i_] = __builtin_amdgcn_exp2f(p1[b_ + i_]); } \
                sm_ = ((p1[b_ + 0] + p1[b_ + 1]) + (p1[b_ + 2] + p1[b_ + 3])) + ((p1[b_ + 4] + p1[b_ + 5]) + (p1[b_ + 6] + p1[b_ + 7])); \
                wv_.x = gm::cvt_pk_bf16(p1[b_ + 0], p1[b_ + 1]); wv_.y = gm::cvt_pk_bf16(p1[b_ + 2], p1[b_ + 3]); wv_.z = gm::cvt_pk_bf16(p1[b_ + 4], p1[b_ + 5]); wv_.w = gm::cvt_pk_bf16(p1[b_ + 6], p1[b_ + 7]); } \
            lpart[s_] = sm_; pb[s_] = __builtin_bit_cast(bf16x8, wv_); } while (0)
            AT_EXPBLK(0);
            const unsigned vaddr = (unsigned)(uintptr_t)(lds + cur * STAGE + 16384 + (4 * hi + ((lane & 15) >> 2)) * 64 + ((lane >> 4) & 1) * 32 + (lane & 3) * 8);
            s16x4 fl[2][4], fh[2][4];
#define AT_TRR(dst, off) asm volatile("ds_read_b64_tr_b16 %0, %1 offset:%c2" : "=&v"(dst) : "v"(vaddr), "i"(off) : "memory")
#pragma unroll
            for (int eb = 0; eb < 4; ++eb) { AT_TRR(fl[0][eb], eb * 4096); AT_TRR(fh[0][eb], eb * 4096 + 512); }
#define AT_PVSTEP(s_) do { \
                if ((s_) < 3) { _Pragma("unroll") for (int eb = 0; eb < 4; ++eb) { AT_TRR(fl[((s_) + 1) & 1][eb], eb * 4096 + ((s_) + 1) * 1024); AT_TRR(fh[((s_) + 1) & 1][eb], eb * 4096 + ((s_) + 1) * 1024 + 512); } \
                    asm volatile("s_waitcnt lgkmcnt(8)" ::: "memory"); } else asm volatile("s_waitcnt lgkmcnt(0)" ::: "memory"); \
                __builtin_amdgcn_sched_barrier(0); \
                _Pragma("unroll") for (int eb = 0; eb < 4; ++eb) { const s16x4 lo = fl[(s_) & 1][eb], hh = fh[(s_) & 1][eb]; \
                    const bf16x8 vf = (bf16x8){lo[0], lo[1], lo[2], lo[3], hh[0], hh[1], hh[2], hh[3]}; \
                    o[eb] = __builtin_amdgcn_mfma_f32_32x32x16_bf16(vf, pb[s_], o[eb], 0, 0, 0); } } while (0)
#define AT_PIN() do { _Pragma("unroll") for (int g_ = 0; g_ < 4; ++g_) { __builtin_amdgcn_sched_group_barrier(0x008, 1, 0); __builtin_amdgcn_sched_group_barrier(0x400, 2, 0); __builtin_amdgcn_sched_group_barrier(0x002, 2, 0); } \
                __builtin_amdgcn_sched_barrier(0); } while (0)
            AT_PVSTEP(0); AT_EXPBLK(1); AT_PIN();
            AT_PVSTEP(1); AT_EXPBLK(2); AT_PIN();
            AT_PVSTEP(2); AT_EXPBLK(3); AT_PIN();
            AT_PVSTEP(3); __builtin_amdgcn_sched_barrier(0);
            lsum += (lpart[0] + lpart[1]) + (lpart[2] + lpart[3]);
#undef AT_EXPBLK
#undef AT_PVSTEP
#undef AT_PIN
#undef AT_TRR
        }
        __syncthreads();
    }
#undef AT_LOAD
#undef AT_STORE
    { const float lt = swap_sum(lsum); const float inv = 1.0f / lt;
#pragma unroll
      for (int eb = 0; eb < 4; ++eb)
#pragma unroll
          for (int r = 0; r < 16; ++r) o[eb][r] *= inv; }
    LAS float* xch = (LAS float*)lds;
    if (m == 1) {
#pragma unroll
        for (int eb = 0; eb < 4; ++eb)
#pragma unroll
            for (int r = 0; r < 16; ++r) xch[(wq * 64 + eb * 16 + r) * 64 + lane] = o[eb][r];
    }
    __syncthreads();
    if (m == 0) {
        float ss = 0.f;
#pragma unroll
        for (int eb = 0; eb < 4; ++eb)
#pragma unroll
            for (int r = 0; r < 16; ++r) { const float v = o[eb][r] - lam * xch[(wq * 64 + eb * 16 + r) * 64 + lane]; o[eb][r] = v; ss += v * v; }
        ss = swap_sum(ss);
        const float rstd = rsqrtf(ss * (1.0f / 128.0f) + EPS) * one_m_li;
        bf16* orow = mix + (size_t)qrow * D + 1536 + h * 128;
#pragma unroll
        for (int eb = 0; eb < 4; ++eb)
#pragma unroll
            for (int rq = 0; rq < 4; ++rq) { const int e0 = 32 * eb + 8 * rq + 4 * hi;
                const f32x4 gq = *(const f32x4*)(subg + e0);
                u32x2 wv; wv.x = gm::cvt_pk_bf16(o[eb][4 * rq + 0] * rstd * gq.x, o[eb][4 * rq + 1] * rstd * gq.y); wv.y = gm::cvt_pk_bf16(o[eb][4 * rq + 2] * rstd * gq.z, o[eb][4 * rq + 3] * rstd * gq.w);
                *(u32x2*)(orow + e0) = wv; }
    }
    __syncthreads();
}
}

namespace s5 {
constexpr int SB_PITCH = 136, YG_PITCH = 520, SB_BYTES = 32 * SB_PITCH * 2;
constexpr int LDS_YG = 0, LDS_SB = 64 * YG_PITCH * 2, LDS_RED = LDS_SB + 8 * SB_BYTES, LDS_S5_BYTES = LDS_RED + 8 * 64 * 4;
static_assert(LDS_S5_BYTES <= LDS_MISC, "s5 lds");

__device__ __forceinline__ void scan16(f32x16& re, f32x16& im, float ar, float ai, float& cr, float& ci, int hi) {
    float sr = hi ? 0.f : cr, si = hi ? 0.f : ci;
#pragma unroll
    for (int r = 0; r < 16; ++r) { const float nr = ar * sr - ai * si + re[r], ni = ar * si + ai * sr + im[r]; sr = nr; si = ni; re[r] = sr; im[r] = si; }
    float xr = partner32(sr, hi), xi = partner32(si, hi);
    xr = hi ? xr : 0.f; xi = hi ? xi : 0.f;
    float pr = ar, pi = ai; asm volatile("" : "+v"(pr), "+v"(pi));
#pragma unroll
    for (int r = 0; r < 16; ++r) { re[r] += pr * xr - pi * xi; im[r] += pr * xi + pi * xr; const float t = pr * ar - pi * ai; pi = pr * ai + pi * ar; pr = t; }
    const float er = partner32(re[15], hi), ei = partner32(im[15], hi);
    cr = hi ? re[15] : er; ci = hi ? im[15] : ei;
}

template <bool FINAL>
__device__ __forceinline__ void s5_group(int lane, const unsigned char* tab, const bf16* __restrict__ proj, f32x2* E, int c, int g, LAS bf16* sbuf, LAS bf16* yg) {
    const int r32 = lane & 31, hi = lane >> 5;
    const f32x2* abar = (const f32x2*)(tab + S5T_ABAR);
    const bf16* bmat = (const bf16*)(tab + S5T_BMAT) + (size_t)g * 128 * 16; const bf16* cmat = (const bf16*)(tab + S5T_CMAT) + (size_t)g * 32 * CM_PITCH;
    const f32x2 a0 = abar[g * 64 + r32], a1 = abar[g * 64 + 32 + r32];
    bf16x8 bfr[4];
#pragma unroll
    for (int pt = 0; pt < 4; ++pt) bfr[pt] = *(const bf16x8*)(bmat + (32 * pt + r32) * 16 + 8 * hi);
    float c0r = 0.f, c0i = 0.f, c1r = 0.f, c1i = 0.f;
    if (FINAL) { const f32x2 v0 = E[((size_t)c * 32 + g) * 64 + r32], v1 = E[((size_t)c * 32 + g) * 64 + 32 + r32]; c0r = v0.x; c0i = v0.y; c1r = v1.x; c1i = v1.y; }
    const int tok0 = 64 * c + 16 * ((r32 >> 2) & 1) + 4 * (r32 >> 3) + (r32 & 3);
    const bf16x8 ufr0 = *(const bf16x8*)(proj + (size_t)tok0 * PW + C_S5U + 16 * g + 8 * hi), ufr1 = *(const bf16x8*)(proj + (size_t)(tok0 + 32) * PW + C_S5U + 16 * g + 8 * hi);
    bf16x8 dfr0 = ufr0, dfr1 = ufr1;
    if (FINAL) { dfr0 = *(const bf16x8*)(proj + (size_t)(64 * c + r32) * PW + C_S5U + 16 * g + 8 * hi); dfr1 = *(const bf16x8*)(proj + (size_t)(64 * c + 32 + r32) * PW + C_S5U + 16 * g + 8 * hi); }
#pragma unroll 1
    for (int tt = 0; tt < 2; ++tt) {
        const int t0 = 64 * c + 32 * tt;
        const bf16x8 ufr = tt ? ufr1 : ufr0;
        f32x16 acc[4];
#pragma unroll
        for (int pt = 0; pt < 4; ++pt) acc[pt] = __builtin_amdgcn_mfma_f32_32x32x16_bf16(ufr, bfr[pt], (f32x16){}, 0, 0, 0);
        scan16(acc[0], acc[2], a0.x, a0.y, c0r, c0i, hi);
        scan16(acc[1], acc[3], a1.x, a1.y, c1r, c1i, hi);
        if (FINAL) {
            LAS bf16* sw = sbuf + (16 * hi) * SB_PITCH + r32;
#pragma unroll
            for (int pt = 0; pt < 4; ++pt)
#pragma unroll
                for (int r = 0; r < 16; ++r) sw[r * SB_PITCH + 32 * pt] = (bf16)f2bf(acc[pt][r]);
            asm volatile("s_waitcnt lgkmcnt(0)" ::: "memory");
            f32x16 y = (f32x16){};
            const LAS bf16* sr = sbuf + r32 * SB_PITCH + 8 * hi; const bf16* cr_ = cmat + r32 * CM_PITCH + 8 * hi;
#pragma unroll
            for (int ks = 0; ks < 8; ++ks) { const bf16x8 afr = *(const LAS bf16x8*)(sr + 16 * ks); const bf16x8 cfr = *(const bf16x8*)(cr_ + 16 * ks);
                y = __builtin_amdgcn_mfma_f32_32x32x16_bf16(afr, cfr, y, 0, 0, 0); }
            { const bf16x8 afr = tt ? dfr1 : dfr0; const bf16x8 cfr = *(const bf16x8*)(cr_ + 128);
              y = __builtin_amdgcn_mfma_f32_32x32x16_bf16(afr, cfr, y, 0, 0, 0); }
            if (r32 < 16) { LAS bf16* yw = yg + (32 * tt + 4 * hi) * YG_PITCH + 16 * g + r32;
#pragma unroll
                for (int r = 0; r < 16; ++r) yw[((r & 3) + 8 * (r >> 2)) * YG_PITCH] = (bf16)f2bf(gelu_tanh(y[r])); }
            asm volatile("s_waitcnt lgkmcnt(0)" ::: "memory");
        }
    }
    if (!FINAL) { E[((size_t)c * 32 + g) * 64 + r32 + 32 * hi] = hi ? (f32x2){c1r, c1i} : (f32x2){c0r, c0i}; }
}

__device__ __forceinline__ void s5_carry_scan(const unsigned char* tab, const f32x2* E, f32x2* Sin, int g, int lane) {
    const f32x2 al = ((const f32x2*)(tab + S5T_AL))[g * 64 + lane];
    const f32x2* e0 = E + (size_t)g * 64 + lane; f32x2* s0 = Sin + (size_t)g * 64 + lane;
    float sr = 0.f, si = 0.f;
#pragma unroll 1
    for (int cb = 0; cb < 256; cb += 16) {
        f32x2 v[16];
#pragma unroll
        for (int i = 0; i < 16; ++i) v[i] = e0[(size_t)(cb + i) * 2048];
#pragma unroll
        for (int i = 0; i < 16; ++i) { s0[(size_t)(cb + i) * 2048] = (f32x2){sr, si}; const float t = al.x * sr - al.y * si + v[i].x; si = al.x * si + al.y * sr + v[i].y; sr = t; }
    }
}

__device__ __forceinline__ void s5_carry_scan_par(const unsigned char* tab, const f32x2* E, f32x2* Sin, int g, int lane, int w, LAS unsigned char* lds) {
    const f32x2 al = ((const f32x2*)(tab + S5T_AL))[g * 64 + lane];
    const f32x2* e0 = E + ((size_t)(32 * w) * 32 + g) * 64 + lane; f32x2* s0 = Sin + ((size_t)(32 * w) * 32 + g) * 64 + lane;
    f32x2 v[32];
#pragma unroll
    for (int i = 0; i < 32; ++i) v[i] = e0[(size_t)i * 2048];
    float sr = 0.f, si = 0.f;
#pragma unroll
    for (int i = 0; i < 32; ++i) { const float er = v[i].x, ei = v[i].y; v[i] = (f32x2){sr, si}; const float t = al.x * sr - al.y * si + er; si = al.x * si + al.y * sr + ei; sr = t; }
    LAS f32x2* tot = (LAS f32x2*)lds;
    tot[w * 64 + lane] = (f32x2){sr, si};
    float pr = al.x, pi = al.y;
#pragma unroll
    for (int k = 0; k < 5; ++k) { const float t = pr * pr - pi * pi; pi = 2.0f * pr * pi; pr = t; }
    __syncthreads();
    float cr = 0.f, ci = 0.f;
    for (int k = 0; k < w; ++k) { const f32x2 tk = tot[k * 64 + lane]; const float t = pr * cr - pi * ci + tk.x; ci = pr * ci + pi * cr + tk.y; cr = t; }
    float qr = 1.f, qi = 0.f;
#pragma unroll
    for (int i = 0; i < 32; ++i) { s0[(size_t)i * 2048] = (f32x2){v[i].x + qr * cr - qi * ci, v[i].y + qr * ci + qi * cr}; const float t = qr * al.x - qi * al.y; qi = qr * al.y + qi * al.x; qr = t; }
}

__device__ __forceinline__ void s5_final_chunk(const Frame& F, const unsigned char* tab, const bf16* __restrict__ proj, f32x2* E, const bf16* __restrict__ wglu_t, const float* mixg, bf16* mix, int c) {
    int lane = lane_id(); asm volatile("" : "+v"(lane));
    const int w = F.wave, r32 = lane & 31, hi = lane >> 5;
    LAS bf16* yg = (LAS bf16*)(F.lds + LDS_YG); LAS bf16* sbuf = (LAS bf16*)(F.lds + LDS_SB + w * SB_BYTES); LAS float* red = (LAS float*)(F.lds + LDS_RED);
#pragma unroll 1
    for (int gi = 0; gi < 4; ++gi) s5_group<true>(lane, tab, proj, E, c, 4 * w + gi, sbuf, yg);
    __syncthreads();
    f32x16 z[2][2];
#pragma unroll
    for (int a = 0; a < 2; ++a)
#pragma unroll
        for (int b = 0; b < 2; ++b) z[a][b] = (f32x16){};
    const int n0 = 64 * w;
    const bf16* wr_ = wglu_t + (size_t)(n0 + r32) * GW + 8 * hi; const LAS bf16* yr_ = yg + r32 * YG_PITCH + 8 * hi;
#pragma unroll 8
    for (int ks = 0; ks < 32; ++ks) {
        bf16x8 afr[2], bfr[2];
#pragma unroll
        for (int nt = 0; nt < 2; ++nt) afr[nt] = *(const bf16x8*)(wr_ + (size_t)(32 * nt) * GW + 16 * ks);
#pragma unroll
        for (int tt = 0; tt < 2; ++tt) bfr[tt] = *(const LAS bf16x8*)(yr_ + (32 * tt) * YG_PITCH + 16 * ks);
#pragma unroll
        for (int nt = 0; nt < 2; ++nt)
#pragma unroll
            for (int tt = 0; tt < 2; ++tt) z[nt][tt] = __builtin_amdgcn_mfma_f32_32x32x16_bf16(afr[nt], bfr[tt], z[nt][tt], 0, 0, 0);
    }
#pragma unroll
    for (int tt = 0; tt < 2; ++tt) { const int t = 32 * tt + r32; float ss = 0.f;
#pragma unroll
        for (int nt = 0; nt < 2; ++nt)
#pragma unroll
            for (int rq = 0; rq < 4; ++rq) { const int n4 = n0 + 32 * nt + 8 * rq + 4 * hi; const u32x2 yv = *(const LAS u32x2*)(yg + t * YG_PITCH + n4);
                const float y0 = bflo(yv.x), y1 = bfhi(yv.x), y2 = bflo(yv.y), y3 = bfhi(yv.y);
                float v;
                v = y0 * sigmoidf_(z[nt][tt][4 * rq + 0]); z[nt][tt][4 * rq + 0] = v; ss += v * v;
                v = y1 * sigmoidf_(z[nt][tt][4 * rq + 1]); z[nt][tt][4 * rq + 1] = v; ss += v * v;
                v = y2 * sigmoidf_(z[nt][tt][4 * rq + 2]); z[nt][tt][4 * rq + 2] = v; ss += v * v;
                v = y3 * sigmoidf_(z[nt][tt][4 * rq + 3]); z[nt][tt][4 * rq + 3] = v; ss += v * v; }
        ss = swap_sum(ss);
        if (hi == 0) red[w * 64 + t] = ss; }
    __syncthreads();
#pragma unroll
    for (int tt = 0; tt < 2; ++tt) { const int t = 32 * tt + r32; float tot = 0.f;
#pragma unroll
        for (int ww = 0; ww < 8; ++ww) tot += red[ww * 64 + t];
        const float rstd = rsqrtf(tot * (1.0f / 512.0f) + EPS);
        bf16* orow = mix + (size_t)(64 * c + t) * D;
#pragma unroll
        for (int nt = 0; nt < 2; ++nt)
#pragma unroll
            for (int rq = 0; rq < 4; ++rq) { const int n4 = n0 + 32 * nt + 8 * rq + 4 * hi; const f32x4 gq = *(const f32x4*)(mixg + n4);
                u32x2 wv; wv.x = gm::cvt_pk_bf16(z[nt][tt][4 * rq + 0] * rstd * gq.x, z[nt][tt][4 * rq + 1] * rstd * gq.y); wv.y = gm::cvt_pk_bf16(z[nt][tt][4 * rq + 2] * rstd * gq.z, z[nt][tt][4 * rq + 3] * rstd * gq.w);
                *(u32x2*)(orow + n4) = wv; } }
    __syncthreads();
}
}

__device__ __forceinline__ void conv_row(const Frame& F, const bf16* __restrict__ proj, const float* cw, const float* mixg, bf16* mix, int t) {
    int lane = lane_id(); asm volatile("" : "+v"(lane));
    const int c0 = 8 * lane;
    float z[3][8];
#pragma unroll
    for (int k = 0; k < 3; ++k) { const int tt = t - 2 + k;
        if (tt >= 0) { const u32x4 a = *(const u32x4*)(proj + (size_t)tt * PW + C_CC + c0), b = *(const u32x4*)(proj + (size_t)tt * PW + C_CH + c0);
            z[k][0] = bflo(a.x) * bflo(b.x); z[k][1] = bfhi(a.x) * bfhi(b.x); z[k][2] = bflo(a.y) * bflo(b.y); z[k][3] = bfhi(a.y) * bfhi(b.y);
            z[k][4] = bflo(a.z) * bflo(b.z); z[k][5] = bfhi(a.z) * bfhi(b.z); z[k][6] = bflo(a.w) * bflo(b.w); z[k][7] = bfhi(a.w) * bfhi(b.w); }
        else {
#pragma unroll
            for (int j = 0; j < 8; ++j) z[k][j] = 0.f; } }
    const u32x4 bb = *(const u32x4*)(proj + (size_t)t * PW + C_CB + c0);
    const float bv[8] = {bflo(bb.x), bfhi(bb.x), bflo(bb.y), bfhi(bb.y), bflo(bb.z), bfhi(bb.z), bflo(bb.w), bfhi(bb.w)};
    float o[8]; float ss = 0.f;
#pragma unroll
    for (int j = 0; j < 8; ++j) { const float cv = cw[c0 + j] * z[0][j] + cw[GW + c0 + j] * z[1][j] + cw[2 * GW + c0 + j] * z[2][j]; o[j] = bv[j] * cv; ss += o[j] * o[j]; }
    ss = wave_sum(ss);
    const float rstd = rsqrtf(ss * (1.0f / 512.0f) + EPS);
    u32x4 wv; wv.x = pk2(o[0] * rstd * mixg[c0], o[1] * rstd * mixg[c0 + 1]); wv.y = pk2(o[2] * rstd * mixg[c0 + 2], o[3] * rstd * mixg[c0 + 3]);
    wv.z = pk2(o[4] * rstd * mixg[c0 + 4], o[5] * rstd * mixg[c0 + 5]); wv.w = pk2(o[6] * rstd * mixg[c0 + 6], o[7] * rstd * mixg[c0 + 7]);
    *(u32x4*)(mix + (size_t)t * D + 512 + c0) = wv;
}

namespace sgu {
constexpr int LDS_V = 0, LDS_RED = 131072, LDS_SGU_BYTES = LDS_RED + 4 * 128 * 4;
static_assert(LDS_SGU_BYTES <= LDS_MISC, "sgu lds");
__device__ __forceinline__ void sgu_block(const Frame& F, const bf16* __restrict__ proj, const float* lng, const float* lnb, const bf16* __restrict__ wsb, const float* sb, const float* mixg, bf16* mix, int blk) {
    int lane = lane_id(); asm volatile("" : "+v"(lane));
    LAS unsigned char* lds = F.lds; LAS float* red = (LAS float*)(lds + LDS_RED);
    const int w = F.wave, r32 = lane & 31, hi = lane >> 5, t0 = 128 * blk;
    u32x4 araw[16];
#pragma unroll
    for (int jj = 0; jj < 16; ++jj) araw[jj] = *(const u32x4*)(proj + (size_t)(t0 + w + 8 * jj) * PW + C_SV + 8 * lane);
#pragma unroll
    for (int jj = 0; jj < 16; ++jj) { const int j = w + 8 * jj;
        const int c0 = 8 * lane; const u32x4 a = araw[jj];
        float v[8] = {bflo(a.x), bfhi(a.x), bflo(a.y), bfhi(a.y), bflo(a.z), bfhi(a.z), bflo(a.w), bfhi(a.w)};
        float s = 0.f;
#pragma unroll
        for (int q = 0; q < 8; ++q) { v[q] = gelu_tanh(v[q]); s += v[q]; }
        const float mean = wave_sum(s) * (1.0f / 512.0f); float s2 = 0.f;
#pragma unroll
        for (int q = 0; q < 8; ++q) { v[q] -= mean; s2 += v[q] * v[q]; }
        const float rstd = rsqrtf(wave_sum(s2) * (1.0f / 512.0f) + EPS);
#pragma unroll
        for (int q = 0; q < 8; ++q) v[q] = v[q] * rstd * lng[c0 + q] + lnb[c0 + q];
        u32x4 o; o.x = pk2(v[0], v[1]); o.y = pk2(v[2], v[3]); o.z = pk2(v[4], v[5]); o.w = pk2(v[6], v[7]);
        *(LAS u32x4*)(lds + LDS_V + (lane >> 2) * 8192 + j * 64 + (lane & 3) * 16) = o;
    }
    __syncthreads();
    const int h = w >> 1, ih = w & 1;
    f32x16 acc[4][2];
#pragma unroll
    for (int ct = 0; ct < 4; ++ct)
#pragma unroll
        for (int it = 0; it < 2; ++it) acc[ct][it] = (f32x16){};
    const LAS unsigned char* vb = lds + LDS_V + (4 * h) * 8192 + (4 * hi + ((lane & 15) >> 2)) * 64 + ((lane >> 4) & 1) * 32 + (lane & 3) * 8;
    const bf16* wrow = wsb + ((size_t)h * 128 + 64 * ih + r32) * 128 + 4 * hi;
    const int nks = ih ? 8 : 4;
#pragma unroll 1
    for (int ks = 0; ks < nks; ++ks) {
        bf16x8 bfr[2];
#pragma unroll
        for (int it = 0; it < 2; ++it) { const u32x2 b0 = *(const u32x2*)(wrow + (32 * it) * 128 + 16 * ks), b1 = *(const u32x2*)(wrow + (32 * it) * 128 + 16 * ks + 8);
            bfr[it] = __builtin_bit_cast(bf16x8, (u32x4){b0.x, b0.y, b1.x, b1.y}); }
#pragma unroll
        for (int ct = 0; ct < 4; ++ct) { const s16x4 lo = at::vtr(vb + ct * 8192 + (16 * ks) * 64), hh = at::vtr(vb + ct * 8192 + (16 * ks + 8) * 64);
            const bf16x8 afr = (bf16x8){lo[0], lo[1], lo[2], lo[3], hh[0], hh[1], hh[2], hh[3]};
#pragma unroll
            for (int it = 0; it < 2; ++it) acc[ct][it] = __builtin_amdgcn_mfma_f32_32x32x16_bf16(afr, bfr[it], acc[ct][it], 0, 0, 0); }
    }
#pragma unroll
    for (int it = 0; it < 2; ++it) { const int i = 64 * ih + 32 * it + r32; const float bsv = sb[h * 128 + i]; float ss = 0.f;
        const bf16* srow = proj + (size_t)(t0 + i) * PW + C_SU + h * 128 + 4 * hi;
#pragma unroll
        for (int ct = 0; ct < 4; ++ct)
#pragma unroll
            for (int rq = 0; rq < 4; ++rq) { const u32x2 uv = *(const u32x2*)(srow + 32 * ct + 8 * rq);
                float v;
                v = gelu_tanh(bflo(uv.x)) * (acc[ct][it][4 * rq + 0] + bsv); acc[ct][it][4 * rq + 0] = v; ss += v * v;
                v = gelu_tanh(bfhi(uv.x)) * (acc[ct][it][4 * rq + 1] + bsv); acc[ct][it][4 * rq + 1] = v; ss += v * v;
                v = gelu_tanh(bflo(uv.y)) * (acc[ct][it][4 * rq + 2] + bsv); acc[ct][it][4 * rq + 2] = v; ss += v * v;
                v = gelu_tanh(bfhi(uv.y)) * (acc[ct][it][4 * rq + 3] + bsv); acc[ct][it][4 * rq + 3] = v; ss += v * v; }
        ss = swap_sum(ss);
        if (hi == 0) red[h * 128 + i] = ss; }
    __syncthreads();
#pragma unroll
    for (int it = 0; it < 2; ++it) { const int i = 64 * ih + 32 * it + r32;
        const float tot = (red[i] + red[128 + i]) + (red[256 + i] + red[384 + i]);
        const float rstd = rsqrtf(tot * (1.0f / 512.0f) + EPS);
        bf16* orow = mix + (size_t)(t0 + i) * D + 1024 + h * 128 + 4 * hi; const float* gp = mixg + h * 128 + 4 * hi;
#pragma unroll
        for (int ct = 0; ct < 4; ++ct)
#pragma unroll
            for (int rq = 0; rq < 4; ++rq) { const f32x4 gq = *(const f32x4*)(gp + 32 * ct + 8 * rq);
                u32x2 wv; wv.x = gm::cvt_pk_bf16(acc[ct][it][4 * rq + 0] * rstd * gq.x, acc[ct][it][4 * rq + 1] * rstd * gq.y); wv.y = gm::cvt_pk_bf16(acc[ct][it][4 * rq + 2] * rstd * gq.z, acc[ct][it][4 * rq + 3] * rstd * gq.w);
                *(u32x2*)(orow + 32 * ct + 8 * rq) = wv; } }
    __syncthreads();
}
}

namespace rt {
constexpr int LDS_PART = 0, LDS_SEL = 32768, LDS_SC = LDS_SEL + 64 * 65 * 4, LDS_E = LDS_SC + 64 * 65 * 4, LDS_R = LDS_E + 64 * 8 * 4;
__device__ __forceinline__ void ln_router_tile(const Frame& F, const bf16* yf, const float* g1, const float* b1, bf16* x1b, bf16* x1l, unsigned char* x1q, const bf16* __restrict__ rthi, const bf16* __restrict__ rtlo,
                                               const float* rbias, int* selE, float* selW, int* selR, int* cnt, int tile) {
    int tid = F.wave * 64 + lane_id(); asm volatile("" : "+v"(tid));
    LAS unsigned char* lds = F.lds; const int lane = tid & 63, w = F.wave, r32 = lane & 31, hi = lane >> 5, t0 = 64 * tile;
    for (int rp1 = 0; rp1 < 1 + ((REPMASK >> 15) & 1); ++rp1)
#pragma unroll 1
    for (int rq = 0; rq < 8; rq += 4) {
    u32x2 yraw[4][8];
#pragma unroll
    for (int r4 = 0; r4 < 4; ++r4) { const u32x2* yr = (const u32x2*)(yf + (size_t)(t0 + 8 * w + rq + r4) * D) + lane;
#pragma unroll
        for (int j = 0; j < 8; ++j) yraw[r4][j] = yr[64 * j]; }
#pragma unroll
    for (int r4 = 0; r4 < 4; ++r4) {
        const int t = t0 + 8 * w + rq + r4;
        f32x4 v[8]; float s = 0.f;
#pragma unroll
        for (int j = 0; j < 8; ++j) { const u32x2 y = yraw[r4][j]; v[j] = (f32x4){bflo(y.x), bfhi(y.x), bflo(y.y), bfhi(y.y)}; s += (v[j].x + v[j].y) + (v[j].z + v[j].w); }
        const float mean = wave_sum(s) * (1.0f / D); float s2 = 0.f;
#pragma unroll
        for (int j = 0; j < 8; ++j) { v[j] = v[j] - mean; s2 += (v[j].x * v[j].x + v[j].y * v[j].y) + (v[j].z * v[j].z + v[j].w * v[j].w); }
        const float rstd = rsqrtf(wave_sum(s2) * (1.0f / D) + EPS);
#pragma unroll
        for (int j = 0; j < 8; ++j) { const int c = 4 * lane + 256 * j; const f32x4 gg = *(const f32x4*)(g1 + c), bb = *(const f32x4*)(b1 + c);
            const f32x4 o = v[j] * rstd * gg + bb;
            u32x2 wh; wh.x = pk2(o.x, o.y); wh.y = pk2(o.z, o.w); *(u32x2*)(x1b + (size_t)t * D + c) = wh;
            u32x2 wl; wl.x = pk2(o.x - bflo(wh.x), o.y - bfhi(wh.x)); wl.y = pk2(o.z - bflo(wh.y), o.w - bfhi(wh.y)); *(u32x2*)(x1l + (size_t)t * D + c) = wl;
            if (x1q) *(unsigned*)(x1q + (size_t)t * D + c) = pk4_fp8(o.x, o.y, o.z, o.w); }
    }
    }
    __threadfence_block();
    __syncthreads();
    for (int rp2 = 0; rp2 < 1 + ((REPMASK >> 16) & 1); ++rp2)
    { const int tt = w >> 2, et = (w >> 1) & 1, kh = w & 1;
      asm volatile("" ::: "memory");
      f32x16 acc = (f32x16){};
      const int mm = w >> 1; const bf16* mbase = (mm == 0) ? x1b + (size_t)t0 * D : (mm == 1) ? x1l + (size_t)t0 * D : (mm == 2) ? rthi : rtlo;
      const bf16* gp[4];
#pragma unroll
      for (int i = 0; i < 4; ++i) { const int row = 32 * (w & 1) + 8 * i + (lane >> 3); gp[i] = mbase + (size_t)row * D + 8 * ((lane & 7) ^ ((row >> 1) & 7)); }
      const unsigned dbase = (unsigned)mm * 8192u + (unsigned)(w & 1) * 4096u;
#define RT_DMA(c) do { _Pragma("unroll") for (int i = 0; i < 4; ++i) \
          __builtin_amdgcn_global_load_lds((const unsigned*)(gp[i] + 64 * (c)), (LAS unsigned*)(lds + ((c) & 3) * 32768 + dbase + i * 1024), 16, 0, 0); } while (0)
      RT_DMA(0); RT_DMA(1); RT_DMA(2);
      const int ra = 32 * tt + r32, rb = 32 * et + r32, sa = (ra >> 1) & 7, sb = (rb >> 1) & 7;
#pragma unroll 1
      for (int c = 0; c < 32; ++c) {
          if (c < 30) asm volatile("s_waitcnt vmcnt(8)" ::: "memory"); else if (c == 30) asm volatile("s_waitcnt vmcnt(4)" ::: "memory"); else asm volatile("s_waitcnt vmcnt(0)" ::: "memory");
          asm volatile("s_waitcnt lgkmcnt(0)" ::: "memory");
          __builtin_amdgcn_s_barrier();
          asm volatile("" ::: "memory"); __builtin_amdgcn_sched_barrier(0);
          if (c + 3 < 32) RT_DMA(c + 3);
          const LAS unsigned char* bb = lds + (c & 3) * 32768;
#pragma unroll
          for (int s2 = 0; s2 < 2; ++s2) { const int ch = 2 * (2 * kh + s2) + hi;
              const bf16x8 a_h = *(const LAS bf16x8*)(bb + ra * 128 + ((ch ^ sa) * 16)), a_l = *(const LAS bf16x8*)(bb + 8192 + ra * 128 + ((ch ^ sa) * 16));
              const bf16x8 b_h = *(const LAS bf16x8*)(bb + 16384 + rb * 128 + ((ch ^ sb) * 16)), b_l = *(const LAS bf16x8*)(bb + 24576 + rb * 128 + ((ch ^ sb) * 16));
              acc = __builtin_amdgcn_mfma_f32_32x32x16_bf16(a_l, b_h, acc, 0, 0, 0); acc = __builtin_amdgcn_mfma_f32_32x32x16_bf16(a_h, b_l, acc, 0, 0, 0); acc = __builtin_amdgcn_mfma_f32_32x32x16_bf16(a_h, b_h, acc, 0, 0, 0); }
          asm volatile("" ::: "memory");
      }
#undef RT_DMA
      asm volatile("s_waitcnt lgkmcnt(0)" ::: "memory");
      __builtin_amdgcn_s_barrier();
      asm volatile("" ::: "memory");
      LAS float* part = (LAS float*)(lds + LDS_PART) + kh * 4096;
#pragma unroll
      for (int r = 0; r < 16; ++r) part[(32 * tt + crow(r, hi)) * 64 + 32 * et + r32] = acc[r];
    }
    __syncthreads();
    LAS float* sel = (LAS float*)(lds + LDS_SEL); LAS float* sc = (LAS float*)(lds + LDS_SC); LAS int* sE = (LAS int*)(lds + LDS_E); LAS int* sR = (LAS int*)(lds + LDS_R);
    { const LAS float* part = (const LAS float*)(lds + LDS_PART);
      for (int i = tid; i < 4096; i += NTHR) { const int t = i >> 6, e = i & 63; const float s = sigmoid_div(part[i] + part[4096 + i]); sc[t * 65 + e] = s; sel[t * 65 + e] = s + rbias[e]; } }
    __syncthreads();
    LAS unsigned* mk = (LAS unsigned*)(lds + LDS_R + 2048);
    if (tid < 128) mk[tid] = 0u;
    {
        const int tl = lane >> 3, g = lane & 7, t = 8 * w + tl; const LAS float* sl = sel + t * 65 + 8 * g;
        float v[8];
#pragma unroll
        for (int q = 0; q < 8; ++q) v[q] = sl[q];
        float m1 = -INFINITY, m2 = -INFINITY;
#pragma unroll
        for (int q = 0; q < 8; ++q) { if (v[q] > m1) { m2 = m1; m1 = v[q]; } else if (v[q] > m2) m2 = v[q]; }
        const float gs = m1 + m2; int rank = 0;
#pragma unroll
        for (int d = 1; d < 8; ++d) { const int og = (g + d) & 7; const float o = shfl_xor_l(gs, lane, g ^ og); rank += (o > gs || (o == gs && og < g)) ? 1 : 0; }
        if (rank >= 4) {
#pragma unroll
            for (int q = 0; q < 8; ++q) v[q] = -INFINITY; }
        float wsum = 0.f, myw = 0.f; int mye = 0;
#pragma unroll
        for (int k = 0; k < 8; ++k) {
            float bv = v[0]; int bi = 8 * g;
#pragma unroll
            for (int q = 1; q < 8; ++q) if (v[q] > bv) { bv = v[q]; bi = 8 * g + q; }
#pragma unroll
            for (int x = 1; x < 8; x <<= 1) { const float ov = shfl_xor_l(bv, lane, x); const int oi = __builtin_bit_cast(int, shfl_xor_l(__builtin_bit_cast(float, bi), lane, x));
                if (ov > bv || (ov == bv && oi < bi)) { bv = ov; bi = oi; } }
#pragma unroll
            for (int q = 0; q < 8; ++q) if (bi == 8 * g + q) v[q] = -INFINITY;
            const float sv = sc[t * 65 + bi]; wsum += sv;
            if (g == k) { myw = sv; mye = bi; }
        }
        const float sc_ = 2.5f / (wsum + 1e-20f);
        sE[t * 8 + g] = mye; selE[(size_t)(t0 + t) * 8 + g] = mye; selW[(size_t)(t0 + t) * 8 + g] = myw * sc_;
    }
    __syncthreads();
    { const int t = tid >> 3; const int e = sE[tid]; __hip_atomic_fetch_or(mk + 2 * e + (t >> 5), 1u << (t & 31), __ATOMIC_RELAXED, __HIP_MEMORY_SCOPE_WORKGROUP); }
    __syncthreads();
    { const int t = tid >> 3; const int e = sE[tid]; const unsigned lo_ = mk[2 * e], hi2 = mk[2 * e + 1];
      const int rk = (t < 32) ? __builtin_popcount(lo_ & ((1u << t) - 1u)) : __builtin_popcount(lo_) + __builtin_popcount(hi2 & ((1u << (t - 32)) - 1u));
      selR[(size_t)t0 * 8 + tid] = rk; }
    if (tid < 64) cnt[tile * 64 + tid] = __builtin_popcount(mk[2 * tid]) + __builtin_popcount(mk[2 * tid + 1]);
    __syncthreads();
}
}

namespace sc {
__device__ __forceinline__ void scatter_tile(const Frame& F, const int* cnt, const int* selE, const int* selR, int* rowtok, int* slot, int* etab, int tile) {
    LAS int* ps = (LAS int*)F.lds;
    int tid = F.wave * 64 + lane_id(); asm volatile("" : "+v"(tid));
    const int e = tid & 63, q = tid >> 6;
    { int tot = 0, off = 0; int cv[32];
#pragma unroll
      for (int i = 0; i < 32; ++i) cv[i] = cnt[(q + 8 * i) * 64 + e];
#pragma unroll
      for (int i = 0; i < 32; ++i) { tot += cv[i]; off += (q + 8 * i < tile) ? cv[i] : 0; }
      ps[q * 64 + e] = tot; ps[512 + q * 64 + e] = off; }
    __syncthreads();
    if (tid < 64) { int tot = 0, off = 0;
#pragma unroll
        for (int k = 0; k < 8; ++k) { tot += ps[k * 64 + tid]; off += ps[512 + k * 64 + tid]; }
        ps[1024 + tid] = tot; ps[1088 + tid] = off; }
    __syncthreads();
    if (tid == 0) { int tp = 0;
        for (int k = 0; k < 64; ++k) { ps[1152 + k] = tp; tp += (ps[1024 + k] + 255) >> 8; }
        ps[1152 + 64] = tp; ps[1152 + 65] = tp + 64; }
    __syncthreads();
    if (tile == 0 && tid < 66) etab[tid] = ps[1152 + tid];
    { const int t = tid >> 3, k = tid & 7, tg = tile * 64 + t; const int ee = selE[(size_t)tg * 8 + k]; const int pos = ps[1152 + ee] * 256 + ps[1088 + ee] + selR[(size_t)tg * 8 + k];
      rowtok[pos] = tg; slot[(size_t)tg * 8 + k] = pos; }
    if (tid < 64) rowtok[ps[1152 + 64] * 256 + tile * 64 + tid] = tile * 64 + tid;
    if (tile < 64) { const int b0 = ps[1152 + tile] * 256 + ps[1024 + tile], b1 = ps[1152 + tile + 1] * 256;
        for (int p = b0 + tid; p < b1; p += NTHR) rowtok[p] = 0; }
    __syncthreads();
}
}

template <bool YS8>
__device__ __forceinline__ void combine_row(const Frame& F, const bf16* __restrict__ ys, const int* slot, const float* selW, const bf16* x1b, const float* g2, const float* b2, float* xout, bf16* xb, int sh_base, int t, bool last) {
    int lane = lane_id(); asm volatile("" : "+v"(lane));
    LAS float* vs = (LAS float*)(F.lds + F.wave * 8192) + lane * 8;
    constexpr int YB = YS8 ? 1 : 2;
    unsigned ro[9]; float wk[9];
#pragma unroll
    for (int k = 0; k < 8; ++k) { ro[k] = (unsigned)slot[(size_t)t * 8 + k] * (unsigned)(D * YB); wk[k] = selW[(size_t)t * 8 + k] * (YS8 ? 1.0f / YS8SCALE : 1.0f); }
    ro[8] = (unsigned)(sh_base + t) * (unsigned)(D * YB); wk[8] = YS8 ? 1.0f / YS8SCALE : 1.0f;
    const char* ysb = (const char*)ys + 8 * YB * lane; const bf16* xr = x1b + (size_t)t * D + 8 * lane;
    float s = 0.f;
    u32x2 y8[YS8 ? 4 : 1][9]; u32x4 xq4[YS8 ? 4 : 1];
    if constexpr (YS8) {
#pragma unroll
        for (int j = 0; j < 4; ++j) {
#pragma unroll
            for (int k = 0; k < 9; ++k) y8[j][k] = *(const u32x2*)(ysb + ro[k] + 512 * j);
            xq4[j] = *(const u32x4*)(xr + 512 * j); }
    }
#pragma unroll
    for (int j = 0; j < 4; ++j) {
        float a[8] = {0.f, 0.f, 0.f, 0.f, 0.f, 0.f, 0.f, 0.f};
        if constexpr (YS8) {
            const u32x2 (&y)[9] = y8[j];
#pragma unroll
            for (int k = 0; k < 9; ++k) { const f32x2 q0 = __builtin_amdgcn_cvt_pk_f32_fp8((int)y[k].x, false), q1 = __builtin_amdgcn_cvt_pk_f32_fp8((int)y[k].x, true), q2 = __builtin_amdgcn_cvt_pk_f32_fp8((int)y[k].y, false), q3 = __builtin_amdgcn_cvt_pk_f32_fp8((int)y[k].y, true);
                a[0] += q0.x * wk[k]; a[1] += q0.y * wk[k]; a[2] += q1.x * wk[k]; a[3] += q1.y * wk[k]; a[4] += q2.x * wk[k]; a[5] += q2.y * wk[k]; a[6] += q3.x * wk[k]; a[7] += q3.y * wk[k]; }
        } else {
            u32x4 y[9];
#pragma unroll
            for (int k = 0; k < 9; ++k) y[k] = *(const u32x4*)(ysb + ro[k] + 1024 * j);
#pragma unroll
            for (int k = 0; k < 9; ++k) { a[0] += bflo(y[k].x) * wk[k]; a[1] += bfhi(y[k].x) * wk[k]; a[2] += bflo(y[k].y) * wk[k]; a[3] += bfhi(y[k].y) * wk[k];
                a[4] += bflo(y[k].z) * wk[k]; a[5] += bfhi(y[k].z) * wk[k]; a[6] += bflo(y[k].w) * wk[k]; a[7] += bfhi(y[k].w) * wk[k]; }
        }
        u32x4 xq; if constexpr (YS8) xq = xq4[j]; else xq = *(const u32x4*)(xr + 512 * j);
        const f32x4 xa = (f32x4){bflo(xq.x), bfhi(xq.x), bflo(xq.y), bfhi(xq.y)}, xb4 = (f32x4){bflo(xq.z), bfhi(xq.z), bflo(xq.w), bfhi(xq.w)};
        const f32x4 va = xa * ALPHA + (f32x4){a[0], a[1], a[2], a[3]}, vb = xb4 * ALPHA + (f32x4){a[4], a[5], a[6], a[7]};
        *(LAS f32x4*)(vs + 512 * j) = va; *(LAS f32x4*)(vs + 512 * j + 4) = vb;
        s += ((va.x + va.y) + (va.z + va.w)) + ((vb.x + vb.y) + (vb.z + vb.w)); }
    const float mean = wave_sum(s) * (1.0f / D); float s2 = 0.f;
#pragma unroll
    for (int j = 0; j < 4; ++j) { const f32x4 va = *(const LAS f32x4*)(vs + 512 * j) - mean, vb = *(const LAS f32x4*)(vs + 512 * j + 4) - mean;
        s2 += ((va.x * va.x + va.y * va.y) + (va.z * va.z + va.w * va.w)) + ((vb.x * vb.x + vb.y * vb.y) + (vb.z * vb.z + vb.w * vb.w)); }
    const float rstd = rsqrtf(wave_sum(s2) * (1.0f / D) + EPS);
    float* orow = xout + (size_t)t * D + 8 * lane; bf16* brow = xb + (size_t)t * D + 8 * lane;
#pragma unroll 1
    for (int j = 0; j < 4; ++j) { const int c = 8 * lane + 512 * j;
        const f32x4 ga = *(const f32x4*)(g2 + c), gb = *(const f32x4*)(g2 + c + 4), ba = *(const f32x4*)(b2 + c), bb = *(const f32x4*)(b2 + c + 4);
        const f32x4 oa = (*(const LAS f32x4*)(vs + 512 * j) - mean) * rstd * ga + ba, ob = (*(const LAS f32x4*)(vs + 512 * j + 4) - mean) * rstd * gb + bb;
        if (last) { *(f32x4*)(orow + 512 * j) = oa; *(f32x4*)(orow + 512 * j + 4) = ob; }
        u32x4 wv; wv.x = pk2(oa.x, oa.y); wv.y = pk2(oa.z, oa.w); wv.z = pk2(ob.x, ob.y); wv.w = pk2(ob.z, ob.w); *(u32x4*)(brow + 512 * j) = wv; }
}

constexpr int NPPL = 10, NPH = 1 + NPPL * DEPTH, CONV_LO = 8192;
__global__ void __launch_bounds__(NTHR, 2) fwd(Args args) {
    extern __shared__ __attribute__((aligned(16))) unsigned char lds_raw[];
    Frame F;
    F.lds = (LAS unsigned char*)lds_raw;
    F.wave = __builtin_amdgcn_readfirstlane(threadIdx.x >> 6);
    F.G = gridDim.x; { const int bx = blockIdx.x; F.vcu = (F.G % 8 == 0) ? (bx % 8) * (F.G / 8) + bx / 8 : bx; }
    volatile LAS unsigned* MISC = (volatile LAS unsigned*)(F.lds + LDS_MISC);
    if (threadIdx.x < 64) MISC[threadIdx.x] = 0u;
    __syncthreads();
    typedef const __attribute__((address_space(4))) Args* KArgs;
#define PHASE_ENV() KArgs ka = (KArgs)__builtin_amdgcn_kernarg_segment_ptr(); asm volatile("" : "+s"(ka)); unsigned char* const ws = ka->ws; (void)ws; \
    Frame Fp; Fp.lds = F.lds; { int w_ = F.wave, v_ = F.vcu, g_ = F.G; asm volatile("" : "+s"(w_), "+s"(v_), "+s"(g_)); Fp.wave = w_; Fp.vcu = v_; Fp.G = g_; } \
    const int gw = Fp.vcu * NWAVES + Fp.wave, NGW = Fp.G * NWAVES; (void)gw; (void)NGW
#define XB_   ((bf16*)(ws + WS_XB))
#define PROJ_ ((bf16*)(ws + WS_PROJ))
#define MIX_  ((bf16*)(ws + WS_MIX))
#define YFB_  ((bf16*)(ws + WS_YF))
#define X1Q_  ((unsigned char*)(ws + WS_X1F))
#define X1B_  ((bf16*)(ws + WS_X1B))
#define X1L_  ((bf16*)(ws + WS_X1L))
#define HB_   ((bf16*)(ws + WS_H))
#define YS_   ((bf16*)(ws + WS_YS))
#define ETAB_ ((int*)(ws + WS_ETAB))
#define CNT_  ((int*)(ws + WS_CNT))
#define SELE_ ((int*)(ws + WS_SELE))
#define SELW_ ((float*)(ws + WS_SELW))
#define SELR_ ((int*)(ws + WS_SELR))
#define SLOT_ ((int*)(ws + WS_SLOT))
#define ROWTOK_ ((int*)(ws + WS_ROWTOK))
#define S5E_  ((f32x2*)(ws + WS_S5E))
#define S5IN_ ((f32x2*)(ws + WS_S5IN))
#define S5TAB_ (ws + WS_S5TAB + (size_t)l * S5TAB_STRIDE)
#define MIXG_ (ka->in[3] + l * 1536)
#if MK_ONE_LAUNCH
    XcdBarrier bar = xcd_barrier_post((unsigned*)(args.ws + WS_CTL) + CW_BAR, MISC + 8);
#define GRID_BAR() do { xcd_barrier(bar); if ((REPMASK >> 17) & 1) xcd_barrier(bar); } while (0)
#else
#define GRID_BAR() do { } while (0)
#endif
    const int lo = args.ph_lo, hi_ = args.ph_hi;
#ifndef PHMASK
#define PHMASK 0x7fff
#endif
#define EN(j) (((PHMASK) >> (j)) & 1)
#ifndef REPMASK
#define REPMASK 0
#endif
#define REP(j) for (int rep_ = 0; rep_ < 1 + (((REPMASK) >> (j)) & 1); ++rep_)
#define IN(k) (lo <= (k) && (k) < hi_)
#define BOTH(k) (IN(k) && IN((k) + 1))

    if (EN(0) && IN(0)) { REP(0) p0_prologue(F, args); if (BOTH(0)) GRID_BAR(); }

    for (int l = 0; l < DEPTH; ++l) {
        const int pb = 1 + NPPL * l;
        if (EN(1) && IN(pb + 0)) {
            PHASE_ENV(); int bx_ = blockIdx.x; asm volatile("" : "+s"(bx_));
            gm::Gemm g{XB_, (const bf16*)(ws + WS_WIN) + (size_t)l * PW * D, D, nullptr, 0};
            gm::DenseOrder S; gm::EpiBf16 E{PROJ_, PW, 1.0f};
            const bool ovl = (l == 0 && Fp.G == 256);
            if (ovl) S.init(T, C_Q, 128, bx_ - 128); else S.init(T, C_Q, Fp.G, bx_);
            if (ovl && bx_ < 128) convert_items(Fp, TI_WIN, TI_TOTAL - TI_DEFER, bx_ * NWAVES + Fp.wave, 128 * NWAVES);
            else { REP(1) gm::gemm_phase<gm::EpiBf16, gm::DenseOrder, false>(Fp.lds, Fp.wave, g, S, E);
                if (ovl) {
                    gm::Gemm g2{XB_, (const bf16*)(ws + WS_WIN) + (size_t)l * PW * D + (size_t)C_Q * D, D, nullptr, 0};
                    gm::DenseOrder S2; S2.init(T, PW - C_Q, 128, bx_ - 128);
                    gm::EpiBf16 E2{PROJ_ + C_Q, PW, 1.0f};
                    gm::gemm_phase<gm::EpiBf16, gm::DenseOrder, false>(Fp.lds, Fp.wave, g2, S2, E2); } }
            if (BOTH(pb + 0)) GRID_BAR();
        }
        if (EN(2) && IN(pb + 1)) {
            PHASE_ENV(); int bx_ = blockIdx.x; asm volatile("" : "+s"(bx_));
            const bool l0 = (l == 0 && Fp.G == 256);
            if (EN(1) && !l0) {
                gm::Gemm g{XB_, (const bf16*)(ws + WS_WIN) + (size_t)l * PW * D + (size_t)C_Q * D, D, nullptr, 0};
                gm::DenseOrder S; S.init(T, PW - C_Q, Fp.G, bx_);
                gm::EpiBf16 E{PROJ_ + C_Q, PW, 1.0f};
                REP(1) gm::gemm_phase<gm::EpiBf16, gm::DenseOrder, false>(Fp.lds, Fp.wave, g, S, E);
            }
            const bool split = (Fp.G == 256); const int half = Fp.G >> 1;
            const bool hiw = split && bx_ >= half;
            if (EN(10) && !(l0 && hiw)) REP(10) for (int c = split ? bx_ : Fp.vcu; c < 256; c += l0 ? half : Fp.G) {
                int lane_ = lane_id(); asm volatile("" : "+v"(lane_));
#pragma unroll 1
                for (int gi = 0; gi < 4; ++gi) s5::s5_group<false>(lane_, S5TAB_, PROJ_, S5E_, c, 4 * Fp.wave + gi, nullptr, nullptr);
            }
            if (EN(11)) REP(11) {
                const int clo = l0 ? 12288 : CONV_LO; const int t_lo = !split ? 0 : hiw ? clo : 0, t_hi = !split ? T : hiw ? T : clo, idx = !split ? Fp.vcu : hiw ? bx_ - half : bx_, cnt = split ? half : Fp.G;
#pragma unroll 2
                for (int t = t_lo + idx * NWAVES + Fp.wave; t < t_hi; t += cnt * NWAVES) conv_row(Fp, PROJ_, ka->in[13] + (size_t)l * 3 * GW, MIXG_ + 512, MIX_, t);
            }
            if (EN(12) && (!split || hiw)) REP(12) for (int blk = split ? bx_ - half : Fp.vcu; blk < 128; blk += split ? half : Fp.G)
                sgu::sgu_block(Fp, PROJ_, ka->in[14] + l * GW, ka->in[15] + l * GW, (const bf16*)(ws + WS_SGUW) + (size_t)l * 65536, ka->in[17] + l * 512, MIXG_ + 1024, MIX_, blk);
            if (l == 0) { __syncthreads(); convert_items(Fp, TI_TOTAL - TI_DEFER, TI_TOTAL, gw, NGW); }
            if (BOTH(pb + 1)) GRID_BAR();
        }
        if (EN(2) && IN(pb + 2)) {
            PHASE_ENV();
            if (EN(14)) REP(14) for (int g = Fp.vcu; g < 32; g += Fp.G) { int lane_ = lane_id(); asm volatile("" : "+v"(lane_)); s5::s5_carry_scan_par(S5TAB_, S5E_, S5IN_, g, lane_, Fp.wave, Fp.lds); __syncthreads(); }
            if (EN(13)) {
                int ln_ = lane_id(); asm volatile("" : "+v"(ln_));
                float d1 = ka->in[18][l * 64 + ln_] * ka->in[19][l * 64 + ln_], d2 = ka->in[20][l * 64 + ln_] * ka->in[21][l * 64 + ln_];
                d1 = wave_sum(d1); d2 = wave_sum(d2);
                const float lam_init = (l == 0) ? 0.2f : 0.35550906f;
                const float lam = expf(d1) - expf(d2) + lam_init;
                REP(13) for (int p = Fp.vcu; p < 256; p += Fp.G) { const int h = p >> 6, s = p & 63;
#pragma unroll 1
                    for (int u2 = 0; u2 < 2; ++u2) at::attn_unit(Fp, PROJ_, MIX_, ka->in[23], ka->in[22] + l * 128, h, u2 ? s : 127 - s, lam, 1.0f - lam_init); }
            }
            if (BOTH(pb + 2)) GRID_BAR();
        }
        if (EN(3) && IN(pb + 3)) {
            PHASE_ENV();
            REP(3) for (int c = Fp.vcu; c < 256; c += Fp.G)
                s5::s5_final_chunk(Fp, S5TAB_, PROJ_, S5IN_, (const bf16*)(ws + WS_WGLU) + (size_t)l * GW * GW, MIXG_, MIX_, c);
            if (BOTH(pb + 3)) GRID_BAR();
        }
        if (EN(4) && IN(pb + 4)) {
            PHASE_ENV(); int bx_ = blockIdx.x; asm volatile("" : "+s"(bx_));
            gm::Gemm g{MIX_, (const bf16*)(ws + WS_WOUT) + (size_t)l * D * D, D, nullptr, 0};
            gm::DenseOrder S; S.init(T, D, Fp.G, bx_);
            gm::EpiResBf16 E{YFB_, XB_, D, ALPHA};
            REP(4) gm::gemm_phase<gm::EpiResBf16, gm::DenseOrder, false>(Fp.lds, Fp.wave, g, S, E);
            if (BOTH(pb + 4)) GRID_BAR();
        }
        if (EN(5) && IN(pb + 5)) {
            PHASE_ENV();
            REP(5) for (int tile = Fp.vcu; tile < 256; tile += Fp.G)
                rt::ln_router_tile(Fp, YFB_, ka->in[24] + l * D, ka->in[25] + l * D, X1B_, X1L_, (l >= FP8_FIRST) ? X1Q_ : nullptr, (const bf16*)(ws + WS_RT) + (size_t)l * 2 * NEXP * D, (const bf16*)(ws + WS_RT) + (size_t)l * 2 * NEXP * D + (size_t)NEXP * D,
                                   ka->in[27] + l * NEXP, SELE_, SELW_, SELR_, CNT_, tile);
            if (BOTH(pb + 5)) GRID_BAR();
        }
        if (EN(6) && IN(pb + 6)) {
            PHASE_ENV();
            REP(6) for (int tile = Fp.vcu; tile < 256; tile += Fp.G) sc::scatter_tile(Fp, CNT_, SELE_, SELR_, ROWTOK_, SLOT_, ETAB_, tile);
            if (BOTH(pb + 6)) GRID_BAR();
        }
        if (EN(7) && IN(pb + 7)) {
            PHASE_ENV();
            LAS int* tp = (LAS int*)(Fp.lds + LDS_MISC - 512);
            { int t_ = Fp.wave * 64 + lane_id(); asm volatile("" : "+v"(t_)); if (t_ < 66) tp[t_] = ETAB_[t_]; }
            __syncthreads();
            if (l >= FP8_FIRST) {
                gm::Gemm g{X1Q_, ws + WS_WGU + (size_t)l * NE1 * 1024 * D * 2, D, ROWTOK_, (size_t)1024 * D};
                gm::GroupOrder S{tp, 4, Fp.G, Fp.vcu, 0};
                gm::EpiSwiGlu<(DOWN_FP8 != 0)> E{HB_, 1.0f / W8SCALE};
                REP(7) { S.ecur = 0; gm::gemm_phase<gm::EpiSwiGlu<(DOWN_FP8 != 0)>, gm::GroupOrder, true, true>(Fp.lds, Fp.wave, g, S, E); }
            } else {
                gm::Gemm g{X1B_, ws + WS_WGU + (size_t)l * NE1 * 1024 * D * 2, D, ROWTOK_, (size_t)1024 * D * 2};
                gm::GroupOrder S{tp, 4, Fp.G, Fp.vcu, 0};
                gm::EpiSwiGlu<false> E{HB_, 1.0f};
                REP(7) { S.ecur = 0; gm::gemm_phase<gm::EpiSwiGlu<false>, gm::GroupOrder, true, false>(Fp.lds, Fp.wave, g, S, E); }
            }
            if (BOTH(pb + 7)) GRID_BAR();
        }
        if (EN(8) && IN(pb + 8)) {
            PHASE_ENV();
            LAS int* tp = (LAS int*)(Fp.lds + LDS_MISC - 512);
            { int t_ = Fp.wave * 64 + lane_id(); asm volatile("" : "+v"(t_)); if (t_ < 66) tp[t_] = ETAB_[t_]; }
            __syncthreads();
            if (DOWN_FP8 && l >= FP8_FIRST) {
                gm::Gemm g{HB_, ws + WS_WDN + (size_t)l * NE1 * D * DEXP * 2, DEXP, nullptr, (size_t)D * DEXP};
                gm::GroupOrder S{tp, 8, Fp.G, Fp.vcu, 0};
                gm::EpiStore<true> E{YS_, D, YS8SCALE / W8SCALE};
                REP(8) { S.ecur = 0; gm::gemm_phase<gm::EpiStore<true>, gm::GroupOrder, false, true>(Fp.lds, Fp.wave, g, S, E); }
            } else {
                gm::Gemm g{HB_, ws + WS_WDN + (size_t)l * NE1 * D * DEXP * 2, DEXP, nullptr, (size_t)D * DEXP * 2};
                gm::GroupOrder S{tp, 8, Fp.G, Fp.vcu, 0};
                gm::EpiBf16 E{YS_, D, 1.0f};
                REP(8) { S.ecur = 0; gm::gemm_phase<gm::EpiBf16, gm::GroupOrder, false, false>(Fp.lds, Fp.wave, g, S, E); }
            }
            if (BOTH(pb + 8)) GRID_BAR();
        }
        if (EN(9) && IN(pb + 9)) {
            PHASE_ENV();
            const int sh_base = ETAB_[64] * 256;
            if (DOWN_FP8 && l >= FP8_FIRST) { REP(9) for (int t = gw; t < T; t += NGW) combine_row<true>(Fp, YS_, SLOT_, SELW_, X1B_, ka->in[32] + l * D, ka->in[33] + l * D, ka->out, XB_, sh_base, t, l == DEPTH - 1); }
            else { REP(9) for (int t = gw; t < T; t += NGW) combine_row<false>(Fp, YS_, SLOT_, SELW_, X1B_, ka->in[32] + l * D, ka->in[33] + l * D, ka->out, XB_, sh_base, t, l == DEPTH - 1); }
            if (BOTH(pb + 9)) GRID_BAR();
        }
    }
#undef IN
#undef BOTH
}

extern "C" void kernel_launch(void* const* d_in, const int* in_sizes, int n_in, void* d_out, int out_size, void* d_ws, size_t ws_size, hipStream_t stream) {
    static int grid = 0;
    if (grid == 0) {
        if (n_in != 34 || out_size != T * D || ws_size < WS_END) { fprintf(stderr, "kernel_launch: unexpected shapes (n_in %d, out %d, ws %zu < %zu)\n", n_in, out_size, ws_size, (size_t)WS_END); grid = -1; return; }
        int dev = 0, cus = 0, per_cu = 0;
        if (hipGetDevice(&dev) != hipSuccess || hipDeviceGetAttribute(&cus, hipDeviceAttributeMultiprocessorCount, dev) != hipSuccess) { grid = -1; return; }
        if (hipFuncSetAttribute((const void*)fwd, hipFuncAttributeMaxDynamicSharedMemorySize, LDS_BYTES) != hipSuccess) { fprintf(stderr, "kernel_launch: hipFuncSetAttribute failed\n"); grid = -1; return; }
        if (hipOccupancyMaxActiveBlocksPerMultiprocessor(&per_cu, (const void*)fwd, NTHR, LDS_BYTES) != hipSuccess || per_cu < 1) fprintf(stderr, "kernel_launch: occupancy query says %d\n", per_cu);
        (void)hipGetLastError();
        grid = cus;
    }
    if (grid < 0) return;
    (void)hipMemsetAsync((char*)d_ws + WS_CTL, 0, CTL_ZERO_BYTES, stream);
    Args a{};
    for (int i = 0; i < 34; ++i) a.in[i] = (const float*)d_in[i];
    a.out = (float*)d_out; a.ws = (unsigned char*)d_ws;
#if MK_ONE_LAUNCH
    a.ph_lo = 0; a.ph_hi = NPH;
    hipLaunchKernelGGL(fwd, dim3(grid), dim3(NTHR), LDS_BYTES, stream, a);
#else
    for (int p = 0; p < NPH; ++p) { a.ph_lo = p; a.ph_hi = p + 1; hipLaunchKernelGGL(fwd, dim3(grid), dim3(NTHR), LDS_BYTES, stream, a); }
#endif
}
```

```cpp
#include <hip/hip_runtime.h>
#include <cstdio>
#include <cstdint>

#ifndef REPMASK
#define REPMASK 0
#endif
#ifndef DOWN_FP8
#define DOWN_FP8 1
#endif
#ifndef FP8_FIRST
#define FP8_FIRST 0
#endif
#ifndef MK_ONE_LAUNCH
#define MK_ONE_LAUNCH 1
#endif

#define GAS __attribute__((address_space(1)))
#define LAS __attribute__((address_space(3)))
typedef unsigned short bf16;
typedef short bf16x8 __attribute__((ext_vector_type(8)));
typedef short s16x4 __attribute__((ext_vector_type(4)));
typedef float f32x2 __attribute__((ext_vector_type(2)));
typedef float f32x4 __attribute__((ext_vector_type(4)));
typedef float f32x16 __attribute__((ext_vector_type(16)));
typedef unsigned u32x2 __attribute__((ext_vector_type(2)));
typedef unsigned u32x4 __attribute__((ext_vector_type(4)));
typedef GAS unsigned gu32;
typedef int v8i_t __attribute__((ext_vector_type(8)));
typedef short s16x16_t __attribute__((ext_vector_type(16)));

constexpr int T = 16384, D = 2048, PW = 4608, GW = 512, NEXP = 64, NE1 = 65, DEXP = 512, TOPK = 8, DEPTH = 2;
constexpr int RMAX = 163840;
constexpr int C_S5U = 0, C_CB = 512, C_CC = 1024, C_CH = 1536, C_SU = 2048, C_SV = 2560, C_Q = 3072, C_K = 3584, C_V = 4096;
constexpr float ALPHA = 1.4142135623730951f, LOG2E = 1.4426950408889634f, QSCALE = 0.125f * LOG2E, EPS = 1e-5f;
constexpr int NWAVES = 8, NTHR = 512;

constexpr size_t MiB = 1u << 20;
constexpr size_t WS_CTL = 0, CTL_ZERO_BYTES = 1 * MiB;
constexpr size_t WS_ETAB = 1 * MiB;
constexpr size_t WS_CNT = WS_ETAB + 4096;
constexpr size_t WS_SELE = 2 * MiB;
constexpr size_t WS_SELW = WS_SELE + (size_t)T * 8 * 4;
constexpr size_t WS_SELR = WS_SELW + (size_t)T * 8 * 4;
constexpr size_t WS_SLOT = WS_SELR + (size_t)T * 8 * 4;
constexpr size_t WS_ROWTOK = WS_SLOT + (size_t)T * 8 * 4;
constexpr size_t WS_S5E = 6 * MiB;
constexpr size_t WS_S5TAB = 10 * MiB;
constexpr size_t S5TAB_STRIDE = 512 * 1024, S5T_ABAR = 0, S5T_AL = 16384, S5T_BMAT = 32768, S5T_CMAT = 32768 + 131072;
constexpr int CM_PITCH = 144;
constexpr size_t WS_SGUW = 11 * MiB;
constexpr size_t WS_RT = 12 * MiB;
constexpr size_t WS_WIN = 16 * MiB;
constexpr size_t WS_WOUT = WS_WIN + (size_t)2 * PW * D * 2;
constexpr size_t WS_WGLU = WS_WOUT + (size_t)2 * D * D * 2;
constexpr size_t WS_WGU = WS_WGLU + (size_t)2 * GW * GW * 2;
constexpr size_t WS_WDN = WS_WGU + (size_t)2 * NE1 * 1024 * D * 2;
constexpr size_t WS_XB = WS_WDN + (size_t)2 * NE1 * D * DEXP * 2;
constexpr size_t WS_PROJ = WS_XB + (size_t)T * D * 2;
constexpr size_t WS_MIX = WS_PROJ + (size_t)T * PW * 2;
constexpr size_t WS_YF = WS_MIX + (size_t)T * D * 2;
constexpr size_t WS_X1F = WS_YF + (size_t)T * D * 4;
constexpr size_t WS_X1B = WS_X1F + (size_t)T * D * 4;
constexpr size_t WS_X1L = WS_X1B + (size_t)T * D * 2;
constexpr size_t WS_H = WS_X1L + (size_t)T * D * 2;
constexpr size_t WS_YS = WS_H + (size_t)RMAX * DEXP * 2;
constexpr size_t WS_S5IN = WS_YS + (size_t)RMAX * D * 2;
constexpr size_t WS_END = WS_S5IN + 4 * MiB;
static_assert(WS_ROWTOK + (size_t)RMAX * 4 <= WS_S5E, "ws map");
static_assert(WS_WIN % 256 == 0 && WS_WOUT % 256 == 0 && WS_WGU % 256 == 0 && WS_XB % 256 == 0 && WS_YS % 256 == 0, "ws align");

constexpr int CW_TMO = 0;
constexpr int CW_BAR = 4096;

constexpr int LDS_MISC = 147456 - 256;
constexpr int LDS_BYTES = 147456;

#define RLX_AGENT __ATOMIC_RELAXED, __HIP_MEMORY_SCOPE_AGENT
__device__ __forceinline__ unsigned hw_pk_bf16(float lo, float hi) { typedef __bf16 bf16x2_t __attribute__((ext_vector_type(2))); f32x2 v = {lo, hi}; bf16x2_t b = __builtin_convertvector(v, bf16x2_t); return __builtin_bit_cast(unsigned, b); }
__device__ __forceinline__ unsigned f2bf(float f) { return hw_pk_bf16(f, 0.f) & 0xffffu; }
__device__ __forceinline__ float bf2f(unsigned b) { return __builtin_bit_cast(float, b << 16); }
__device__ __forceinline__ unsigned pk2(float lo, float hi) { return hw_pk_bf16(lo, hi); }
__device__ __forceinline__ unsigned pk4_fp8(float a, float b, float c, float d) { int w = __builtin_amdgcn_cvt_pk_fp8_f32(a, b, 0, false); w = __builtin_amdgcn_cvt_pk_fp8_f32(c, d, w, true); return (unsigned)w; }
constexpr float YS8SCALE = 16.0f;
constexpr float W8SCALE = 32.0f;
__device__ __forceinline__ float bflo(unsigned w) { return __builtin_bit_cast(float, w << 16); }
__device__ __forceinline__ float bfhi(unsigned w) { return __builtin_bit_cast(float, w & 0xffff0000u); }
__device__ __forceinline__ int lane_id() { unsigned z = 0u; asm volatile("" : "+v"(z)); return (int)__builtin_amdgcn_mbcnt_hi(~0u, __builtin_amdgcn_mbcnt_lo(~0u, z)); }
__device__ __forceinline__ float shfl_xor_l(float v, int lane, int m) { return __builtin_bit_cast(float, __builtin_amdgcn_ds_bpermute((lane ^ m) << 2, __builtin_bit_cast(int, v))); }
__device__ __forceinline__ void swap32(float v, float& r0, float& r1) { float a = v, b = v;
    asm volatile("s_nop 1\n\tv_permlane32_swap_b32 %0, %1" : "+v"(a), "+v"(b)); r0 = a; r1 = b; }
__device__ __forceinline__ float swap_sum(float v) { float r0, r1; swap32(v, r0, r1); return r0 + r1; }
__device__ __forceinline__ float swap_max(float v) { float r0, r1; swap32(v, r0, r1); return fmaxf(r0, r1); }
__device__ __forceinline__ float partner32(float v, int hi) { float r0, r1; swap32(v, r0, r1); return hi ? r0 : r1; }
template <int CTRL> __device__ __forceinline__ float dpp_mov(float v) { return __builtin_bit_cast(float, __builtin_amdgcn_update_dpp(0, __builtin_bit_cast(int, v), CTRL, 0xf, 0xf, false)); }
__device__ __forceinline__ float wave_sum(float v) {
    v += dpp_mov<0xB1>(v); v += dpp_mov<0x4E>(v); v += dpp_mov<0x141>(v); v += dpp_mov<0x140>(v);
    v = swap_sum(v);
    const int vi = __builtin_bit_cast(int, v);
    return __builtin_bit_cast(float, __builtin_amdgcn_readlane(vi, 0)) + __builtin_bit_cast(float, __builtin_amdgcn_readlane(vi, 16));
}
__device__ __forceinline__ float gelu_tanh(float x) {
    const float u = 0.7978845608028654f * (x + 0.044715f * x * x * x);
    const float e = __expf(2.0f * u);
    return x - x * __builtin_amdgcn_rcpf(e + 1.0f);
}
__device__ __forceinline__ float sigmoidf_(float x) { return __builtin_amdgcn_rcpf(1.0f + __expf(-x)); }
__device__ __forceinline__ float sigmoid_div(float x) { return 1.0f / (1.0f + __expf(-x)); }
__device__ __forceinline__ int crow(int r, int hi) { return (r & 3) + 8 * (r >> 2) + 4 * hi; }

#define XB_TMO      128
#define XB_XCNT(j)  (256  + 64 * (j))
#define XB_XSUB(j)  (1280 + 64 * (j))
#define XB_XGEN(j)  (2304 + 64 * (j))
#define XB_TOP      3328
#define XB_TOPGEN   3392
#define XCD_BAR_WORDS 3456
#define XB_SPIN_CAP (1u << 22)
__device__ __forceinline__ unsigned xb_ld(unsigned* p)              { return __hip_atomic_load(p, __ATOMIC_RELAXED, __HIP_MEMORY_SCOPE_AGENT); }
__device__ __forceinline__ unsigned xb_add(unsigned* p, unsigned v) { return __hip_atomic_fetch_add(p, v, __ATOMIC_RELAXED, __HIP_MEMORY_SCOPE_AGENT); }
__device__ __forceinline__ unsigned xb_xcc_id() { return (unsigned)__builtin_amdgcn_s_getreg((3 << 11) | 20) & 0xFu; }
#define XB_SPIN(cond, bar) do { unsigned _sp = 0; while (cond) { __builtin_amdgcn_s_sleep(1); \
    if ((++_sp & 255u) == 0u) { if (xb_ld(&(bar)[XB_TMO])) break; if (_sp > XB_SPIN_CAP) { atomicAdd(&(bar)[XB_TMO], 1u); break; } } } } while (0)
struct XcdBarrier { unsigned* bar; unsigned x; volatile LAS unsigned* st; int wave; };
__device__ __forceinline__ XcdBarrier xcd_barrier_post(unsigned* bar, volatile LAS unsigned* st) {
    XcdBarrier b; b.bar = bar; b.x = xb_xcc_id(); b.st = st;
    if (threadIdx.x == 0) (void)xb_add(&bar[XB_XCNT(b.x)], 1u);
    b.wave = __builtin_amdgcn_readfirstlane(threadIdx.x >> 6);
    return b;
}
__device__ __forceinline__ void xcd_barrier_complete(unsigned* bar, unsigned x, unsigned& nloc, unsigned& nx) {
    const unsigned G = gridDim.x * gridDim.y * gridDim.z;
    unsigned sum, cnt, mine, sp = 0u;
    for (;;) {
        sum = 0u; cnt = 0u; mine = 0u;
#pragma unroll
        for (unsigned j = 0; j < 16; ++j) { const unsigned c = xb_ld(&bar[XB_XCNT(j)]); sum += c; cnt += (c > 0u) ? 1u : 0u; mine = (j == x) ? c : mine; }
        if (sum == G) break;
        __builtin_amdgcn_s_sleep(1);
        if ((++sp & 255u) == 0u) { if (xb_ld(&bar[XB_TMO])) break; if (sp > XB_SPIN_CAP) { atomicAdd(&bar[XB_TMO], 1u); break; } }
    }
    nloc = mine > 0u ? mine : 1u; nx = cnt > 0u ? cnt : 1u;
}
__device__ __forceinline__ void xcd_barrier(const XcdBarrier& b) {
    asm volatile("s_waitcnt vmcnt(0)" ::: "memory");
    __syncthreads();
    if (b.wave == 0 && lane_id() == 0) {
        unsigned* bar = b.bar; asm volatile("" : "+s"(bar));
        __builtin_amdgcn_s_waitcnt(0);
        unsigned nloc = b.st[0], nx = b.st[1];
        if (nloc == 0u) { xcd_barrier_complete(bar, b.x, nloc, nx); b.st[0] = nloc; b.st[1] = nx; }
        const unsigned old = xb_add(&bar[XB_XSUB(b.x)], 1u);
        const unsigned gen = old / nloc;
        if (old + 1u == (gen + 1u) * nloc) {
            __builtin_amdgcn_fence(__ATOMIC_RELEASE, "agent");
            asm volatile("s_waitcnt vmcnt(0)" ::: "memory");
            const unsigned og = xb_add(&bar[XB_TOP], 1u);
            const unsigned tg = og / nx;
            if (og + 1u == (tg + 1u) * nx) xb_add(&bar[XB_TOPGEN], 1u);
            else XB_SPIN(xb_ld(&bar[XB_TOPGEN]) == tg, bar);
            __builtin_amdgcn_fence(__ATOMIC_ACQUIRE, "agent");
            xb_add(&bar[XB_XGEN(b.x)], 1u);
            asm volatile("s_waitcnt vmcnt(0)" ::: "memory");
        } else {
            XB_SPIN(xb_ld(&bar[XB_XGEN(b.x)]) == gen, bar);
            __builtin_amdgcn_fence(__ATOMIC_ACQUIRE, "agent");
            asm volatile("s_waitcnt vmcnt(0)" ::: "memory");
        }
    }
    __syncthreads();
}

struct Args { const float* in[34]; float* out; unsigned char* ws; int ph_lo, ph_hi; };
struct Frame {
    LAS unsigned char* lds;
    int wave, vcu, G;
};

namespace gm {
constexpr int BM = 256, BK = 64, HALF = 128;
struct Unit { int pm, pn, e; };
struct Gemm { const void* A; const void* Bt; int K; const int* rowidx; size_t b_estride; };
__host__ __device__ __forceinline__ int perm32(int rho) { const int n = rho >> 4, i = rho & 15; return 8 * (i >> 2) + 4 * n + (i & 3); }

struct DenseOrder {
    int nM, nN, nwg, G, c;
    __device__ void init(int M, int N, int G_, int c_) { nM = M / BM; nN = N / BM; nwg = nM * nN; G = G_; c = c_; }
    __device__ bool next(int i, Unit& u) const {
        const long L = (long)i * G + c; if (L >= nwg) return false;
        int wgid = (int)L; { const int q = nwg / 8, r = nwg % 8, xcd = wgid % 8, off = wgid / 8; wgid = (xcd < r ? xcd * (q + 1) : r * (q + 1) + (xcd - r) * q) + off; }
        const int WGM = 8, nig = WGM * nN, gid = wgid / nig, fm = gid * WGM, gsz = (nM - fm) < WGM ? (nM - fm) : WGM;
        u.pm = fm + ((wgid % nig) % gsz); u.pn = (wgid % nig) / gsz; u.e = 0; return true;
    }
};
struct GroupOrder {
    const LAS int* tp; int NT, G, vcu; mutable int ecur;
    __device__ bool next(int i, Unit& u) const {
        const int L = i * G + vcu; const int total = tp[NE1] * NT; if (L >= total) return false;
        const int tile = L / NT; u.pn = L % NT; u.pm = tile;
        int e = ecur;
        while (tile >= tp[e + 1]) ++e;
        ecur = e; u.e = e; return true;
    }
};

constexpr int HTB = HALF * BK * 2, STAGE_BYTES = 8 * HTB;
__host__ __device__ __forceinline__ int lds_byte(int r, int c) { const int st = (r >> 4) * 2 + (c >> 5), rr = r & 15, cc = c & 31, ob = rr * 64 + cc * 2; return st * 1024 + (ob ^ (((ob >> 9) & 1) << 5)); }
__host__ __device__ __forceinline__ void stage_rc(int b, int& R, int& C) { const int st = b / 1024, sb = b % 1024, swz = sb ^ (((sb >> 9) & 1) << 5); R = (st >> 1) * 16 + swz / 64; C = (st & 1) * 32 + (swz % 64) / 2; }

template <class Epi, class Sched, bool GATHER, bool FP8 = false, bool ALIGN = true>
__device__ __forceinline__ void gemm_phase(LAS unsigned char* lds, int wave, const Gemm g, const Sched& S, const Epi& E) {
    int lane = lane_id(); asm volatile("" : "+v"(lane));
    const int wid = wave, tid = wid * 64 + lane, wr = wid >> 2, wc = wid & 3, fr = lane & 15, fq = lane >> 4;
    const int K = g.K * (FP8 ? 1 : 2), nt = K / 128;
    int Rr[2], Cc[2]; unsigned voffB0[2], voffB1[2];
#pragma unroll
    for (int i = 0; i < 2; ++i) { int R, C; stage_rc(tid * 16 + i * 8192, R, C); Rr[i] = R; Cc[i] = 2 * C;
        int r0, r1;
        if constexpr (Epi::WIDE) { const int rho = R & 31, q = 16 * ((rho & 15) >> 2) + 4 * (rho >> 4) + (rho & 3); r0 = 64 * (R >> 5) + q; r1 = r0 + 8; }
        else { const int Rb = Epi::PERM ? ((R & ~31) + perm32(R & 31)) : R; r0 = Rb; r1 = HALF + Rb; }
        voffB0[i] = (unsigned)(r0 * K + 2 * C); voffB1[i] = (unsigned)(r1 * K + 2 * C); }
    const size_t kstep = 128, hstep = (size_t)HALF * K, tstep = 2 * hstep;
    const unsigned ldsw = (unsigned)wid * 1024u;
    const int aoff = lds_byte(wr * 64 + fr, fq * 8), boff = lds_byte(wc * 32 + fr, fq * 8);
    constexpr int KOFF = 1024;
#define PG8_SA(b, h) (((b) * 2 + (h)) * HTB)
#define PG8_SB(b, h) ((4 + (b) * 2 + (h)) * HTB)
#define PG8_STAGE(bufoff, gbase, voff) do { _Pragma("unroll") for (int _i = 0; _i < 2; ++_i) \
        __builtin_amdgcn_global_load_lds((const unsigned*)((const char*)(gbase) + (voff)[_i]), (LAS unsigned*)(lds + (bufoff) + ldsw + _i * 8192), 16, 0, 0); } while (0)
#define PG8_LDA(dst, b, h) do { _Pragma("unroll") for (int m = 0; m < 4; ++m) _Pragma("unroll") for (int k = 0; k < 2; ++k) dst[m][k] = *(const LAS bf16x8*)(lds + PG8_SA(b, h) + aoff + m * 2048 + k * KOFF); } while (0)
#define PG8_LDB(dst, b, h) do { _Pragma("unroll") for (int n = 0; n < 2; ++n) _Pragma("unroll") for (int k = 0; k < 2; ++k) dst[n][k] = *(const LAS bf16x8*)(lds + PG8_SB(b, h) + boff + n * 2048 + k * KOFF); } while (0)
#define PG8_CAT(x) __builtin_bit_cast(v8i_t, __builtin_shufflevector((x)[0], (x)[1], 0, 1, 2, 3, 4, 5, 6, 7, 8, 9, 10, 11, 12, 13, 14, 15))
#define PG8_MMA(ai, bj, At, Bt) do { __builtin_amdgcn_s_setprio(1); _Pragma("unroll") for (int m = 0; m < 4; ++m) _Pragma("unroll") for (int n = 0; n < 2; ++n) { \
        if constexpr (FP8) acc[ai][bj][m][n] = __builtin_amdgcn_mfma_scale_f32_16x16x128_f8f6f4(PG8_CAT(Bt[n]), PG8_CAT(At[m]), acc[ai][bj][m][n], 0, 0, 0, 0x7F7F7F7F, 0, 0x7F7F7F7F); \
        else { _Pragma("unroll") for (int k = 0; k < 2; ++k) acc[ai][bj][m][n] = __builtin_amdgcn_mfma_f32_16x16x32_bf16(Bt[n][k], At[m][k], acc[ai][bj][m][n], 0, 0, 0); } } \
        __builtin_amdgcn_s_setprio(0); } while (0)
#define PG8_WAIT_V(n) asm volatile("s_waitcnt vmcnt(" #n ")" ::: "memory")
#define PG8_WAIT_L(n) asm volatile("s_waitcnt lgkmcnt(" #n ")" ::: "memory")
#define PG8_BAR __builtin_amdgcn_s_barrier()
#define PG8_SCHED __builtin_amdgcn_sched_barrier(0)
#define PG8_AOFF(u_, o0, o1) do { _Pragma("unroll") for (int _i = 0; _i < 2; ++_i) { const int r0 = (u_).pm * BM + Rr[_i], r1 = r0 + HALF; \
        const int g0 = GATHER ? g.rowidx[r0] : r0, g1 = GATHER ? g.rowidx[r1] : r1; \
        o0[_i] = (unsigned)g0 * (unsigned)K + (unsigned)Cc[_i]; o1[_i] = (unsigned)g1 * (unsigned)K + (unsigned)Cc[_i]; } } while (0)
    Unit cur, nxt; int ui = 0;
    if (!S.next(0, cur)) return;
    f32x4 acc[2][2][4][2];
#pragma unroll
    for (int a = 0; a < 2; ++a)
#pragma unroll
        for (int b = 0; b < 2; ++b)
#pragma unroll
            for (int m = 0; m < 4; ++m)
#pragma unroll
                for (int n = 0; n < 2; ++n) acc[a][b][m][n] = (f32x4){0.f, 0.f, 0.f, 0.f};
    bf16x8 At[4][2], B0[2][2], B1[2][2];
    unsigned ca0[2], ca1[2];
    PG8_AOFF(cur, ca0, ca1);
    const char* Ab = (const char*)g.A;
    const char* cB = (const char*)g.Bt + (size_t)cur.e * g.b_estride + (size_t)cur.pn * tstep;
    PG8_STAGE(PG8_SB(0, 0), cB, voffB0); PG8_STAGE(PG8_SB(0, 1), cB, voffB1); PG8_STAGE(PG8_SA(0, 0), Ab, ca0); PG8_STAGE(PG8_SA(0, 1), Ab, ca1);
    if (wr == 1) PG8_BAR;
    PG8_WAIT_V(2); PG8_BAR;
    PG8_STAGE(PG8_SB(1, 0), cB + kstep, voffB0); PG8_STAGE(PG8_SA(1, 0), Ab + kstep, ca0); PG8_STAGE(PG8_SB(1, 1), cB + kstep, voffB1);
    PG8_WAIT_V(6); PG8_BAR;
    for (;;) {
        const bool has_next = S.next(ui + 1, nxt);
        const char* nB = has_next ? (const char*)g.Bt + (size_t)nxt.e * g.b_estride + (size_t)nxt.pn * tstep : cB;
#pragma unroll 1
        for (int t = 0; t < nt; t += 2) {
            const bool last = (t == nt - 2);
            const char* a1 = Ab + (size_t)(t + 1) * kstep;
            const char* a2 = last ? Ab : Ab + (size_t)(t + 2) * kstep; const char* b2 = last ? nB : cB + (size_t)(t + 2) * kstep;
            const char* a3 = a2 + kstep; const char* b3 = b2 + kstep;
            PG8_LDB(B0, 0, 0); PG8_LDB(B1, 0, 1); PG8_SCHED; PG8_LDA(At, 0, 0); PG8_STAGE(PG8_SA(1, 1), a1, ca1);
            if (last && has_next) PG8_AOFF(nxt, ca0, ca1);
            PG8_WAIT_V(8); PG8_WAIT_L(0); PG8_BAR; PG8_MMA(0, 0, At, B0); PG8_MMA(0, 1, At, B1); PG8_BAR; PG8_SCHED;
            PG8_LDA(At, 0, 1); PG8_STAGE(PG8_SB(0, 0), b2, voffB0); PG8_STAGE(PG8_SB(0, 1), b2, voffB1); PG8_STAGE(PG8_SA(0, 0), a2, ca0);
            PG8_WAIT_V(8); PG8_WAIT_L(0); PG8_BAR; PG8_MMA(1, 0, At, B0); PG8_MMA(1, 1, At, B1); PG8_BAR; PG8_SCHED;
            PG8_LDB(B0, 1, 0); PG8_LDB(B1, 1, 1); PG8_SCHED; PG8_LDA(At, 1, 0); PG8_STAGE(PG8_SA(0, 1), a2, ca1);
            PG8_WAIT_V(8); PG8_WAIT_L(0); PG8_BAR; PG8_MMA(0, 0, At, B0); PG8_MMA(0, 1, At, B1); PG8_BAR; PG8_SCHED;
            PG8_LDA(At, 1, 1); PG8_STAGE(PG8_SB(1, 0), b3, voffB0); PG8_STAGE(PG8_SB(1, 1), b3, voffB1); PG8_STAGE(PG8_SA(1, 0), a3, ca0);
            PG8_WAIT_V(8); PG8_WAIT_L(0); PG8_BAR; PG8_MMA(1, 0, At, B0); PG8_MMA(1, 1, At, B1); PG8_BAR; PG8_SCHED;
        }
        if constexpr (ALIGN) { if (wr == 0) PG8_BAR; }
        E(acc, cur, wr, wc, fr, fq);
        if (!has_next) break;
#pragma unroll
        for (int a = 0; a < 2; ++a)
#pragma unroll
            for (int b = 0; b < 2; ++b)
#pragma unroll
                for (int m = 0; m < 4; ++m)
#pragma unroll
                    for (int n = 0; n < 2; ++n) acc[a][b][m][n] = (f32x4){0.f, 0.f, 0.f, 0.f};
        cur = nxt; cB = nB; ++ui;
        if constexpr (ALIGN) { if (wr == 1) PG8_BAR; }
    }
    PG8_WAIT_V(0);
    if constexpr (!ALIGN) { if (wr == 0) PG8_BAR; }
    PG8_BAR;
#undef PG8_SA
#undef PG8_SB
#undef PG8_STAGE
#undef PG8_LDA
#undef PG8_LDB
#undef PG8_MMA
#undef PG8_CAT
#undef PG8_WAIT_V
#undef PG8_WAIT_L
#undef PG8_BAR
#undef PG8_SCHED
#undef PG8_AOFF
}

__device__ __forceinline__ unsigned cvt_pk_bf16(float lo, float hi) { typedef __bf16 bf16x2_t __attribute__((ext_vector_type(2))); f32x2 v = {lo, hi}; bf16x2_t b = __builtin_convertvector(v, bf16x2_t); return __builtin_bit_cast(unsigned, b); }

template <bool FP8OUT> struct EpiStore {
    static constexpr bool PERM = true, WIDE = true;
    void* O; int ldc; float scale;
    __device__ __forceinline__ void operator()(const f32x4 (&acc)[2][2][4][2], const Unit& u, int wr, int wc, int fr, int fq) const {
        const int row0 = u.pm * BM + wr * 64 + fr, col0 = u.pn * BM + wc * 64 + 16 * fq;
#pragma unroll
        for (int ai = 0; ai < 2; ++ai)
#pragma unroll
            for (int m = 0; m < 4; ++m) { const size_t off = (size_t)(row0 + ai * HALF + m * 16) * ldc + col0;
                const f32x4 v0 = acc[ai][0][m][0] * scale, v1 = acc[ai][0][m][1] * scale, v2 = acc[ai][1][m][0] * scale, v3 = acc[ai][1][m][1] * scale;
                if constexpr (FP8OUT) { u32x4 w; w.x = pk4_fp8(v0[0], v0[1], v0[2], v0[3]); w.y = pk4_fp8(v1[0], v1[1], v1[2], v1[3]); w.z = pk4_fp8(v2[0], v2[1], v2[2], v2[3]); w.w = pk4_fp8(v3[0], v3[1], v3[2], v3[3]);
                    *(u32x4*)((unsigned char*)O + off) = w; }
                else { u32x4 wa, wb; wa.x = cvt_pk_bf16(v0[0], v0[1]); wa.y = cvt_pk_bf16(v0[2], v0[3]); wa.z = cvt_pk_bf16(v1[0], v1[1]); wa.w = cvt_pk_bf16(v1[2], v1[3]);
                    wb.x = cvt_pk_bf16(v2[0], v2[1]); wb.y = cvt_pk_bf16(v2[2], v2[3]); wb.z = cvt_pk_bf16(v3[0], v3[1]); wb.w = cvt_pk_bf16(v3[2], v3[3]);
                    *(u32x4*)((bf16*)O + off) = wa; *(u32x4*)((bf16*)O + off + 8) = wb; } }
    }
};
typedef EpiStore<false> EpiBf16;
struct EpiResBf16 {
    static constexpr bool PERM = true, WIDE = true;
    bf16* O; const bf16* R; int ldc; float alpha;
    __device__ __forceinline__ void operator()(const f32x4 (&acc)[2][2][4][2], const Unit& u, int wr, int wc, int fr, int fq) const {
        const int row0 = u.pm * BM + wr * 64 + fr, col0 = u.pn * BM + wc * 64 + 16 * fq;
#pragma unroll
        for (int ai = 0; ai < 2; ++ai)
#pragma unroll
            for (int m = 0; m < 4; ++m) { const size_t off = (size_t)(row0 + ai * HALF + m * 16) * ldc + col0;
                const u32x4 ra = *(const u32x4*)(R + off), rb = *(const u32x4*)(R + off + 8);
                const f32x4 v0 = acc[ai][0][m][0], v1 = acc[ai][0][m][1], v2 = acc[ai][1][m][0], v3 = acc[ai][1][m][1];
                u32x4 wa, wb;
                wa.x = cvt_pk_bf16(bflo(ra.x) * alpha + v0[0], bfhi(ra.x) * alpha + v0[1]); wa.y = cvt_pk_bf16(bflo(ra.y) * alpha + v0[2], bfhi(ra.y) * alpha + v0[3]);
                wa.z = cvt_pk_bf16(bflo(ra.z) * alpha + v1[0], bfhi(ra.z) * alpha + v1[1]); wa.w = cvt_pk_bf16(bflo(ra.w) * alpha + v1[2], bfhi(ra.w) * alpha + v1[3]);
                wb.x = cvt_pk_bf16(bflo(rb.x) * alpha + v2[0], bfhi(rb.x) * alpha + v2[1]); wb.y = cvt_pk_bf16(bflo(rb.y) * alpha + v2[2], bfhi(rb.y) * alpha + v2[3]);
                wb.z = cvt_pk_bf16(bflo(rb.z) * alpha + v3[0], bfhi(rb.z) * alpha + v3[1]); wb.w = cvt_pk_bf16(bflo(rb.w) * alpha + v3[2], bfhi(rb.w) * alpha + v3[3]);
                *(u32x4*)(O + off) = wa; *(u32x4*)(O + off + 8) = wb; }
    }
};
struct EpiResF32 {
    static constexpr bool PERM = false, WIDE = false;
    float* C; const float* R; int ldc; float alpha;
    __device__ __forceinline__ void operator()(const f32x4 (&acc)[2][2][4][2], const Unit& u, int wr, int wc, int fr, int fq) const {
        const int row0 = u.pm * BM + wr * 64 + fr, col0 = u.pn * BM + wc * 32 + 4 * fq;
#pragma unroll
        for (int ai = 0; ai < 2; ++ai)
#pragma unroll
            for (int m = 0; m < 4; ++m) { const size_t off = (size_t)(row0 + ai * HALF + m * 16) * ldc + col0;
#pragma unroll
                for (int bj = 0; bj < 2; ++bj)
#pragma unroll
                    for (int n = 0; n < 2; ++n) { const f32x4 r = *(const f32x4*)(R + off + bj * HALF + n * 16); *(f32x4*)(C + off + bj * HALF + n * 16) = r * alpha + acc[ai][bj][m][n]; } }
    }
};
template <bool FP8OUT> struct EpiSwiGlu {
    static constexpr bool PERM = true, WIDE = false;
    void* H; float isc;
    __device__ __forceinline__ void operator()(const f32x4 (&acc)[2][2][4][2], const Unit& u, int wr, int wc, int fr, int fq) const {
        const int row0 = u.pm * BM + wr * 64 + fr, col0 = u.pn * HALF + wc * 32 + 8 * fq;
#pragma unroll
        for (int ai = 0; ai < 2; ++ai)
#pragma unroll
            for (int m = 0; m < 4; ++m) { const size_t off = (size_t)(row0 + ai * HALF + m * 16) * DEXP + col0;
                float hv[8];
#pragma unroll
                for (int n = 0; n < 2; ++n)
#pragma unroll
                    for (int j = 0; j < 4; ++j) { const float gg = acc[ai][0][m][n][j] * isc, uu = acc[ai][1][m][n][j] * isc; hv[4 * n + j] = gg * sigmoidf_(gg) * uu; }
                if constexpr (FP8OUT) { u32x2 w; w.x = pk4_fp8(hv[0], hv[1], hv[2], hv[3]); w.y = pk4_fp8(hv[4], hv[5], hv[6], hv[7]); __builtin_nontemporal_store(w, (u32x2*)((unsigned char*)H + off)); }
                else { u32x4 w; w.x = cvt_pk_bf16(hv[0], hv[1]); w.y = cvt_pk_bf16(hv[2], hv[3]); w.z = cvt_pk_bf16(hv[4], hv[5]); w.w = cvt_pk_bf16(hv[6], hv[7]); __builtin_nontemporal_store(w, (u32x4*)((bf16*)H + off)); } }
    }
};
}

struct TItem { const float* src; bf16* dst; int K, N, k0, n0, drow0; float scale; int fp8; };
constexpr int TI_WIN = (D / 64) * (PW / 64), TI_WOUT = (D / 64) * (D / 64), TI_WGLU = (GW / 64) * (GW / 64), TI_GU1 = (D / 64) * (1024 / 64), TI_DN1 = (DEXP / 64) * (D / 64);
constexpr int TI_LAYER = TI_WIN + TI_WOUT + TI_WGLU + NE1 * TI_GU1 + NE1 * TI_DN1, TI_TOTAL = DEPTH * TI_LAYER;
template <class KA>
__device__ __forceinline__ TItem decode_titem(KA ap, unsigned char* ws, int it) {
    TItem t; const int l = it / TI_LAYER; int r = it % TI_LAYER; t.scale = 1.f; t.fp8 = 0;
    if (r < TI_WIN) { const int nnb = PW / 64; t.K = D; t.N = PW; t.k0 = (r / nnb) * 64; t.n0 = (r % nnb) * 64; t.drow0 = t.n0; t.src = ap->in[1] + (size_t)l * D * PW; t.dst = (bf16*)(ws + WS_WIN) + (size_t)l * PW * D;
        t.scale = (t.n0 >= C_Q && t.n0 < C_K) ? QSCALE : 1.f; return t; }
    r -= TI_WIN;
    if (r < TI_WOUT) { const int nnb = D / 64; t.K = D; t.N = D; t.k0 = (r / nnb) * 64; t.n0 = (r % nnb) * 64; t.drow0 = t.n0; t.src = ap->in[2] + (size_t)l * D * D; t.dst = (bf16*)(ws + WS_WOUT) + (size_t)l * D * D; return t; }
    r -= TI_WOUT;
    if (r < TI_WGLU) { const int nnb = GW / 64; t.K = GW; t.N = GW; t.k0 = (r / nnb) * 64; t.n0 = (r % nnb) * 64; t.drow0 = t.n0; t.src = ap->in[12] + (size_t)l * GW * GW; t.dst = (bf16*)(ws + WS_WGLU) + (size_t)l * GW * GW; return t; }
    r -= TI_WGLU;
    if (r < NE1 * TI_GU1) { const int e = r / TI_GU1, q = r % TI_GU1, nnb = 1024 / 64; t.K = D; t.N = 1024; t.k0 = (q / nnb) * 64; t.n0 = (q % nnb) * 64;
        { const int half = t.n0 / 512, j = t.n0 % 512; t.drow0 = 256 * (j / 128) + 128 * half + (j % 128); }
        t.src = (e < NEXP) ? ap->in[28] + ((size_t)l * NEXP + e) * D * 1024 : ap->in[30] + (size_t)l * D * 1024; t.dst = (bf16*)(ws + WS_WGU) + ((size_t)l * NE1 + e) * 1024 * D;
        if (l >= FP8_FIRST) { t.fp8 = 1; t.scale = W8SCALE; t.dst = (bf16*)(ws + WS_WGU + (size_t)l * NE1 * 1024 * D * 2 + (size_t)e * 1024 * D); }
        return t; }
    r -= NE1 * TI_GU1;
    { const int e = r / TI_DN1, q = r % TI_DN1, nnb = D / 64; t.K = DEXP; t.N = D; t.k0 = (q / nnb) * 64; t.n0 = (q % nnb) * 64; t.drow0 = t.n0;
      t.src = (e < NEXP) ? ap->in[29] + ((size_t)l * NEXP + e) * DEXP * D : ap->in[31] + (size_t)l * DEXP * D; t.dst = (bf16*)(ws + WS_WDN) + ((size_t)l * NE1 + e) * D * DEXP;
      if (DOWN_FP8 && l >= FP8_FIRST) { t.fp8 = 1; t.scale = W8SCALE; t.dst = (bf16*)(ws + WS_WDN + (size_t)l * NE1 * D * DEXP * 2 + (size_t)e * D * DEXP); }
      return t; }
}
__device__ __forceinline__ void titem_load(const TItem& t, f32x4 (&v)[16], int lane) {
    const float* p = t.src + (size_t)(t.k0 + (lane >> 4)) * t.N + t.n0 + (lane & 15) * 4;
#pragma unroll
    for (int i = 0; i < 16; ++i) v[i] = __builtin_nontemporal_load((const f32x4*)(p + (size_t)(4 * i) * t.N));
}
__device__ __forceinline__ void titem_to_lds(const f32x4 (&v)[16], LAS float* scr, int lane) {
    LAS float* q = scr + (lane >> 4) * 65 + (lane & 15) * 4;
#pragma unroll
    for (int i = 0; i < 16; ++i) { q[(4 * i) * 65] = v[i].x; q[(4 * i) * 65 + 1] = v[i].y; q[(4 * i) * 65 + 2] = v[i].z; q[(4 * i) * 65 + 3] = v[i].w; }
}
__device__ __forceinline__ void titem_store(const TItem& t, const LAS float* scr, int lane) {
    if (t.fp8) {
        const int c = lane & 3; const float sc = t.scale; unsigned char* d8 = (unsigned char*)t.dst;
#pragma unroll
        for (int j = 0; j < 4; ++j) { const int n = 16 * j + (lane >> 2); const LAS float* s = scr + (16 * c) * 65 + n;
            u32x4 o; o.x = pk4_fp8(s[0] * sc, s[65] * sc, s[2 * 65] * sc, s[3 * 65] * sc); o.y = pk4_fp8(s[4 * 65] * sc, s[5 * 65] * sc, s[6 * 65] * sc, s[7 * 65] * sc);
            o.z = pk4_fp8(s[8 * 65] * sc, s[9 * 65] * sc, s[10 * 65] * sc, s[11 * 65] * sc); o.w = pk4_fp8(s[12 * 65] * sc, s[13 * 65] * sc, s[14 * 65] * sc, s[15 * 65] * sc);
            __builtin_nontemporal_store(o, (u32x4*)(d8 + (size_t)(t.drow0 + n) * t.K + t.k0 + 16 * c)); }
        return; }
    const int c = lane & 7; const float sc = t.scale;
#pragma unroll
    for (int j = 0; j < 8; ++j) { const int n = 8 * j + (lane >> 3); const LAS float* s = scr + (8 * c) * 65 + n;
        u32x4 o; o.x = pk2(s[0] * sc, s[65] * sc); o.y = pk2(s[2 * 65] * sc, s[3 * 65] * sc); o.z = pk2(s[4 * 65] * sc, s[5 * 65] * sc); o.w = pk2(s[6 * 65] * sc, s[7 * 65] * sc);
        __builtin_nontemporal_store(o, (u32x4*)(t.dst + (size_t)(t.drow0 + n) * t.K + t.k0 + 8 * c)); }
}
constexpr int TI_DEFER = 8192;
static_assert(TI_DEFER <= NE1 * TI_DN1, "deferred items must be last-layer down weights");
__device__ __forceinline__ void convert_items(const Frame& F, int first, int last, int rank, int nranks) {
    typedef const __attribute__((address_space(4))) Args* KArgs; KArgs ap = (KArgs)__builtin_amdgcn_kernarg_segment_ptr(); asm volatile("" : "+s"(ap));
    unsigned char* ws = ap->ws;
    int lane = lane_id(); asm volatile("" : "+v"(lane));
    LAS float* scr = (LAS float*)(F.lds + F.wave * 16640);
    f32x4 v[16]; int it = first + rank;
    TItem cur = decode_titem(ap, ws, it < last ? it : 0);
    if (it < last) titem_load(cur, v, lane);
    while (it < last) {
        titem_to_lds(v, scr, lane);
        const int nx = it + nranks; const TItem nxt = decode_titem(ap, ws, nx < last ? nx : 0);
        if (nx < last) titem_load(nxt, v, lane);
        asm volatile("s_waitcnt lgkmcnt(0)" ::: "memory");
        titem_store(cur, scr, lane);
        asm volatile("s_waitcnt lgkmcnt(0)" ::: "memory");
        cur = nxt; it = nx;
    }
}
__device__ __forceinline__ void p0_prologue(const Frame& F, const Args& a_) {
    typedef const __attribute__((address_space(4))) Args* KArgs; KArgs ap = (KArgs)__builtin_amdgcn_kernarg_segment_ptr(); asm volatile("" : "+s"(ap));
#define a (*ap)
    unsigned char* ws = a.ws;
    int lane = lane_id(); asm volatile("" : "+v"(lane));
    LAS float* scr = (LAS float*)(F.lds + F.wave * 16640);
    const int gw = F.vcu * NWAVES + F.wave, NGW = F.G * NWAVES;
    const int gt = gw * 64 + lane, NGT = NGW * 64;
    { const f32x4* x4 = (const f32x4*)a.in[0]; u32x2* o = (u32x2*)(ws + WS_XB);
      for (size_t i = gt; i < (size_t)T * D / 4; i += NGT) { const f32x4 v = x4[i]; u32x2 w; w.x = pk2(v.x, v.y); w.y = pk2(v.z, v.w); o[i] = w; } }
    for (int l = 0; l < DEPTH; ++l) {
        {
            unsigned char* tab = ws + WS_S5TAB + (size_t)l * S5TAB_STRIDE;
            const float* lre = a.in[4] + l * 2048; const float* lim = a.in[5] + l * 2048; const float* ldt = a.in[6] + l * 32;
            const float* bre = a.in[7] + (size_t)l * 32768; const float* bim = a.in[8] + (size_t)l * 32768;
            const float* cre = a.in[9] + (size_t)l * 32768; const float* cim = a.in[10] + (size_t)l * 32768;
            for (int i = gt; i < 2048; i += NGT) {
                const int g = i >> 6; const float dt = expf(ldt[g]); const float ar = lre[i], ai = lim[i];
                const float er = expf(ar * dt); const float sn = sinf(ai * dt), cs = cosf(ai * dt);
                const float abr = er * cs, abi = er * sn;
                ((f32x2*)(tab + S5T_ABAR))[i] = (f32x2){abr, abi};
                const float eL = expf(ar * dt * 64.0f); const float snL = sinf(ai * dt * 64.0f), csL = cosf(ai * dt * 64.0f);
                ((f32x2*)(tab + S5T_AL))[i] = (f32x2){eL * csL, eL * snL};
                const float nr = abr - 1.0f, ni = abi, den = ar * ar + ai * ai;
                const float cr = (nr * ar + ni * ai) / den, ci = (ni * ar - nr * ai) / den;
                bf16* bm = (bf16*)(tab + S5T_BMAT) + (size_t)g * 128 * 16; const int p = i & 63;
#pragma unroll 4
                for (int h = 0; h < 16; ++h) { const float br = bre[(size_t)i * 16 + h], bi = bim[(size_t)i * 16 + h];
                    bm[p * 16 + h] = (bf16)f2bf(cr * br - ci * bi); bm[(64 + p) * 16 + h] = (bf16)f2bf(cr * bi + ci * br); }
            }
            const float* dd = a.in[11] + l * GW;
            for (int i = gt; i < 32 * 32 * CM_PITCH; i += NGT) {
                const int g = i / (32 * CM_PITCH), hh = (i / CM_PITCH) & 31, k = i % CM_PITCH; float v = 0.f;
                if (hh < 16) { if (k < 64) v = cre[((size_t)g * 16 + hh) * 64 + k]; else if (k < 128) v = -cim[((size_t)g * 16 + hh) * 64 + (k - 64)]; else v = (k - 128 == hh) ? dd[16 * g + hh] : 0.f; }
                ((bf16*)(tab + S5T_CMAT))[i] = (bf16)f2bf(v);
            }
        }
        { const float* sw = a.in[16] + (size_t)l * 65536; bf16* o = (bf16*)(ws + WS_SGUW) + (size_t)l * 65536;
          for (int i = gt; i < 65536; i += NGT) o[i] = (bf16)f2bf(sw[i]); }
        {
            const float* rw = a.in[26] + (size_t)l * D * NEXP; bf16* hi = (bf16*)(ws + WS_RT) + (size_t)l * 2 * NEXP * D; bf16* lo = hi + (size_t)NEXP * D;
            for (int i = gt; i < NEXP * D; i += NGT) { const int e = i / D, k = i % D; const float v = rw[(size_t)k * NEXP + e]; const unsigned h = f2bf(v); hi[i] = (bf16)h; lo[i] = (bf16)f2bf(v - bf2f(h)); }
        }
    }
    if (F.G == 256) convert_items(F, 0, TI_WIN, gw, NGW); else convert_items(F, 0, TI_TOTAL - TI_DEFER, gw, NGW);
#undef a
}

namespace at {
constexpr int STAGE = 32768, LDS_LUT = 2 * STAGE, LDS_ATT_BYTES = LDS_LUT + 1024;
__device__ __forceinline__ int t5_bucket(int rel) {
    const int ret = rel > 0 ? 16 : 0; const int n = rel < 0 ? -rel : rel;
    int b;
    if (n < 8) b = n; else if (n < 12) b = 8; else if (n < 16) b = 9; else if (n < 23) b = 10; else if (n < 32) b = 11; else if (n < 46) b = 12; else if (n < 64) b = 13; else if (n < 91) b = 14; else b = 15;
    return ret + b;
}
__device__ __forceinline__ s16x4 vtr(const LAS unsigned char* p) { typedef short v4i16_t __attribute__((ext_vector_type(4))); return __builtin_bit_cast(s16x4, __builtin_amdgcn_ds_read_tr16_b64_v4i16((LAS v4i16_t*)p)); }

__device__ __forceinline__ void attn_unit(const Frame& F, const bf16* __restrict__ proj, bf16* mix, const float* relb, const float* subg, int h, int qb, float lam, float one_m_li) {
    LAS unsigned char* lds = F.lds;
    int tid = F.wave * 64 + lane_id(); asm volatile("" : "+v"(tid));
    const int lane = tid & 63, w = F.wave, r32 = lane & 31, hi = lane >> 5, m = w >> 2, wq = w & 3;
    const int q0 = qb * 128, qrow = q0 + 32 * wq + r32, cw = (q0 + 32 * wq) >> 6, NT = 2 * qb + 2;
    LAS float* lut = (LAS float*)(lds + LDS_LUT);
    if (tid < 256) { const int rel = tid - 192; lut[tid] = (relb[t5_bucket(rel) * 4 + h] - relb[15 * 4 + h]) * LOG2E; }
    bf16x8 qr[4];
#pragma unroll
    for (int d0 = 0; d0 < 4; ++d0) qr[d0] = *(const bf16x8*)(proj + (size_t)qrow * PW + C_Q + h * 128 + m * 64 + 16 * d0 + 8 * hi);
    u32x4 rk[2], rv[2];
    const bf16* kbase = proj + C_K + h * 128; const bf16* vbase = proj + C_V + h * 128;
#define AT_LOAD(j) do { _Pragma("unroll") for (int i = 0; i < 2; ++i) { const int id = tid + 512 * i, row = id >> 4, c16 = id & 15; \
        rk[i] = *(const u32x4*)(kbase + (size_t)(64 * (j) + row) * PW + c16 * 8); rv[i] = *(const u32x4*)(vbase + (size_t)(64 * (j) + row) * PW + c16 * 8); } } while (0)
#define AT_STORE(buf) do { _Pragma("unroll") for (int i = 0; i < 2; ++i) { const int id = tid + 512 * i, row = id >> 4, c16 = id & 15, mk = c16 >> 3, c = c16 & 7; \
        *(LAS u32x4*)(lds + (buf) * STAGE + mk * 8192 + c * 1024 + ((row ^ c) * 16)) = rk[i]; \
        *(LAS u32x4*)(lds + (buf) * STAGE + 16384 + (c16 >> 2) * 4096 + row * 64 + (c16 & 3) * 16) = rv[i]; } } while (0)
    AT_LOAD(0);
    __syncthreads();
    AT_STORE(0);
    AT_LOAD(1);
    __syncthreads();
    float mrun = 0.f, lsum = 0.f;
    f32x16 negm = (f32x16){};
    f32x16 o[4];
#pragma unroll
    for (int eb = 0; eb < 4; ++eb) o[eb] = (f32x16){};
    for (int j = 0; j < NT; ++j) {
        const int cur = j & 1;
        bf16x8 kf[2][2];
        const LAS unsigned char* Kb = lds + cur * STAGE + m * 8192;
        if (j <= cw) {
#pragma unroll
            for (int d0 = 0; d0 < 2; ++d0) { const int c = 2 * d0 + hi; kf[d0][0] = *(const LAS bf16x8*)(Kb + c * 1024 + ((r32 ^ c) * 16)); kf[d0][1] = *(const LAS bf16x8*)(Kb + c * 1024 + ((r32 ^ c) * 16) + 512); } }
        __builtin_amdgcn_sched_barrier(0);
        if (j + 1 < NT) AT_STORE(cur ^ 1);
        if (j + 2 < NT) AT_LOAD(j + 2);
        if (j <= cw) {
            f32x16 p0, p1;
#pragma unroll
            for (int d0 = 0; d0 < 4; ++d0) { const int c = 2 * d0 + hi;
                const bf16x8 a0 = (d0 < 2) ? kf[d0 & 1][0] : *(const LAS bf16x8*)(Kb + c * 1024 + ((r32 ^ c) * 16));
                const bf16x8 a1 = (d0 < 2) ? kf[d0 & 1][1] : *(const LAS bf16x8*)(Kb + c * 1024 + ((r32 ^ c) * 16) + 512);
                if (d0 == 0) { p0 = __builtin_amdgcn_mfma_f32_32x32x16_bf16(a0, qr[0], negm, 0, 0, 0); p1 = __builtin_amdgcn_mfma_f32_32x32x16_bf16(a1, qr[0], negm, 0, 0, 0); }
                else { p0 = __builtin_amdgcn_mfma_f32_32x32x16_bf16(a0, qr[d0], p0, 0, 0, 0); p1 = __builtin_amdgcn_mfma_f32_32x32x16_bf16(a1, qr[d0], p1, 0, 0, 0); } }
            if (j >= cw - 2) {
                const int base = 64 * j - qrow + 192;
#pragma unroll
                for (int r = 0; r < 16; ++r) { const int kv = crow(r, hi); p0[r] += lut[base + kv]; p1[r] += lut[base + kv + 32]; }
            }
            float mx = fmaxf(fmaxf(p0[0], p0[1]), p1[0]), mb = fmaxf(fmaxf(p0[2], p0[3]), p1[1]); mx = fmaxf(fmaxf(mx, p1[2]), p1[3]);
#pragma unroll
            for (int r = 4; r < 16; r += 4) { mx = fmaxf(fmaxf(mx, p0[r]), p0[r + 1]); mb = fmaxf(fmaxf(mb, p0[r + 2]), p0[r + 3]); mx = fmaxf(fmaxf(mx, p1[r]), p1[r + 1]); mb = fmaxf(fmaxf(mb, p1[r + 2]), p1[r + 3]); }
            mx = swap_max(fmaxf(mx, mb));
            if (j == 0 || __any(mx > 8.0f)) {
                const float dl = (j == 0) ? mx : fmaxf(mx, 0.f); mrun += dl;
                const float alpha = __builtin_amdgcn_exp2f(-dl); lsum *= alpha;
#pragma unroll
                for (int r = 0; r < 16; ++r) { p0[r] -= dl; p1[r] -= dl; negm[r] = -mrun; }
#pragma unroll
                for (int eb = 0; eb < 4; ++eb)
#pragma unroll
                    for (int r = 0; r < 16; ++r) o[eb][r] *= alpha;
            }
            bf16x8 pb[4]; float lpart[4];
#define AT_EXPBLK(s_) do { float sm_ = 0.f; u32x4 wv_; \
            if ((s_) < 2) { _Pragma("unroll") for (int i_ = 0; i_ < 8; ++i_) { p0[8 * (s_) + i_] = __builtin_amdgcn_exp2f(p0[8 * (s_) + i_]); } \
                sm_ = ((p0[8 * (s_) + 0] + p0[8 * (s_) + 1]) + (p0[8 * (s_) + 2] + p0[8 * (s_) + 3])) + ((p0[8 * (s_) + 4] + p0[8 * (s_) + 5]) + (p0[8 * (s_) + 6] + p0[8 * (s_) + 7])); \
                wv_.x = gm::cvt_pk_bf16(p0[8 * (s_) + 0], p0[8 * (s_) + 1]); wv_.y = gm::cvt_pk_bf16(p0[8 * (s_) + 2], p0[8 * (s_) + 3]); wv_.z = gm::cvt_pk_bf16(p0[8 * (s_) + 4], p0[8 * (s_) + 5]); wv_.w = gm::cvt_pk_bf16(p0[8 * (s_) + 6], p0[8 * (s_) + 7]); } \
            else { constexpr int b_ = 8 * ((s_) & 1); _Pragma("unroll") for (int i_ = 0; i_ < 8; ++i_) { p1[b_ + i_] = __builtin_amdgcn_exp2f(p1[b_ + i_]); } \
                sm_ = ((p1[b_ + 0] + p1[b_ + 1]) + (p1[b_ + 2] + p1[b_ + 3])) + ((p1[b_ + 4] + p1[b_ + 5]) + (p1[b_ + 6] + p1[b_ + 7])); \
                wv_.x = gm::cvt_pk_bf16(p1[b_ + 0], p1[b_ + 1]); wv_.y = gm::cvt_pk_bf16(p1[b_ + 2], p1[b_ + 3]); wv_.z = gm::cvt_pk_bf16(p1[b_ + 4], p1[b_ + 5]); wv_.w = gm::cvt_pk_bf16(p1[b_ + 6], p1[b_ + 7]); } \
            lpart[s_] = sm_; pb[s_] = __builtin_bit_cast(bf16x8, wv_); } while (0)
            AT_EXPBLK(0);
            const unsigned vaddr = (unsigned)(uintptr_t)(lds + cur * STAGE + 16384 + (4 * hi + ((lane & 15) >> 2)) * 64 + ((lane >> 4) & 1) * 32 + (lane & 3) * 8);
            s16x4 fl[2][4], fh[2][4];
#define AT_TRR(dst, off) asm volatile("ds_read_b64_tr_b16 %0, %1 offset:%c2" : "=&v"(dst) : "v"(vaddr), "i"(off) : "memory")
#pragma unroll
            for (int eb = 0; eb < 4; ++eb) { AT_TRR(fl[0][eb], eb * 4096); AT_TRR(fh[0][eb], eb * 4096 + 512); }
#define AT_PVSTEP(s_) do { \
                if ((s_) < 3) { _Pragma("unroll") for (int eb = 0; eb < 4; ++eb) { AT_TRR(fl[((s_) + 1) & 1][eb], eb * 4096 + ((s_) + 1) * 1024); AT_TRR(fh[((s_) + 1) & 1][eb], eb * 4096 + ((s_) + 1) * 1024 + 512); } \
                    asm volatile("s_waitcnt lgkmcnt(8)" ::: "memory"); } else asm volatile("s_waitcnt lgkmcnt(0)" ::: "memory"); \
                __builtin_amdgcn_sched_barrier(0); \
                _Pragma("unroll") for (int eb = 0; eb < 4; ++eb) { const s16x4 lo = fl[(s_) & 1][eb], hh = fh[(s_) & 1][eb]; \
                    const bf16x8 vf = (bf16x8){lo[0], lo[1], lo[2], lo[3], hh[0], hh[1], hh[2], hh[3]}; \
                    o[eb] = __builtin_amdgcn_mfma_f32_32x32x16_bf16(vf, pb[s_], o[eb], 0, 0, 0); } } while (0)
#define AT_PIN() do { _Pragma("unroll") for (int g_ = 0; g_ < 4; ++g_) { __builtin_amdgcn_sched_group_barrier(0x008, 1, 0); __builtin_amdgcn_sched_group_barrier(0x400, 2, 0); __builtin_amdgcn_sched_group_barrier(0x002, 2, 0); } \
                __builtin_amdgcn_sched_barrier(0); } while (0)
            AT_PVSTEP(0); AT_EXPBLK(1); AT_PIN();
            AT_PVSTEP(1); AT_EXPBLK(2); AT_PIN();
            AT_PVSTEP(2); AT_EXPBLK(3); AT_PIN();
            AT_PVSTEP(3); __builtin_amdgcn_sched_barrier(0);
            lsum += (lpart[0] + lpart[1]) + (lpart[2] + lpart[3]);
#undef AT_EXPBLK
#undef AT_PVSTEP
#undef AT_PIN
#undef AT_TRR
        }
        __syncthreads();
    }
#undef AT_LOAD
#undef AT_STORE
    { const float lt = swap_sum(lsum); const float inv = 1.0f / lt;
#pragma unroll
      for (int eb = 0; eb < 4; ++eb)
#pragma unroll
          for (int r = 0; r < 16; ++r) o[eb][r] *= inv; }
    LAS float* xch = (LAS float*)lds;
    if (m == 1) {
#pragma unroll
        for (int eb = 0; eb < 4; ++eb)
#pragma unroll
            for (int r = 0; r < 16; ++r) xch[(wq * 64 + eb * 16 + r) * 64 + lane] = o[eb][r];
    }
    __syncthreads();
    if (m == 0) {
        float ss = 0.f;
#pragma unroll
        for (int eb = 0; eb < 4; ++eb)
#pragma unroll
            for (int r = 0; r < 16; ++r) { const float v = o[eb][r] - lam * xch[(wq * 64 + eb * 16 + r) * 64 + lane]; o[eb][r] = v; ss += v * v; }
        ss = swap_sum(ss);
        const float rstd = rsqrtf(ss * (1.0f / 128.0f) + EPS) * one_m_li;
        bf16* orow = mix + (size_t)qrow * D + 1536 + h * 128;
#pragma unroll
        for (int eb = 0; eb < 4; ++eb)
#pragma unroll
            for (int rq = 0; rq < 4; ++rq) { const int e0 = 32 * eb + 8 * rq + 4 * hi;
                const f32x4 gq = *(const f32x4*)(subg + e0);
                u32x2 wv; wv.x = gm::cvt_pk_bf16(o[eb][4 * rq + 0] * rstd * gq.x, o[eb][4 * rq + 1] * rstd * gq.y); wv.y = gm::cvt_pk_bf16(o[eb][4 * rq + 2] * rstd * gq.z, o[eb][4 * rq + 3] * rstd * gq.w);
                *(u32x2*)(orow + e0) = wv; }
    }
    __syncthreads();
}
}

namespace s5 {
constexpr int SB_PITCH = 136, YG_PITCH = 520, SB_BYTES = 32 * SB_PITCH * 2;
constexpr int LDS_YG = 0, LDS_SB = 64 * YG_PITCH * 2, LDS_RED = LDS_SB + 8 * SB_BYTES, LDS_S5_BYTES = LDS_RED + 8 * 64 * 4;
static_assert(LDS_S5_BYTES <= LDS_MISC, "s5 lds");

__device__ __forceinline__ void scan16(f32x16& re, f32x16& im, float ar, float ai, float& cr, float& ci, int hi) {
    float sr = hi ? 0.f : cr, si = hi ? 0.f : ci;
#pragma unroll
    for (int r = 0; r < 16; ++r) { const float nr = ar * sr - ai * si + re[r], ni = ar * si + ai * sr + im[r]; sr = nr; si = ni; re[r] = sr; im[r] = si; }
    float xr = partner32(sr, hi), xi = partner32(si, hi);
    xr = hi ? xr : 0.f; xi = hi ? xi : 0.f;
    float pr = ar, pi = ai; asm volatile("" : "+v"(pr), "+v"(pi));
#pragma unroll
    for (int r = 0; r < 16; ++r) { re[r] += pr * xr - pi * xi; im[r] += pr * xi + pi * xr; const float t = pr * ar - pi * ai; pi = pr * ai + pi * ar; pr = t; }
    const float er = partner32(re[15], hi), ei = partner32(im[15], hi);
    cr = hi ? re[15] : er; ci = hi ? im[15] : ei;
}

template <bool FINAL>
__device__ __forceinline__ void s5_group(int lane, const unsigned char* tab, const bf16* __restrict__ proj, f32x2* E, int c, int g, LAS bf16* sbuf, LAS bf16* yg) {
    const int r32 = lane & 31, hi = lane >> 5;
    const f32x2* abar = (const f32x2*)(tab + S5T_ABAR);
    const bf16* bmat = (const bf16*)(tab + S5T_BMAT) + (size_t)g * 128 * 16; const bf16* cmat = (const bf16*)(tab + S5T_CMAT) + (size_t)g * 32 * CM_PITCH;
    const f32x2 a0 = abar[g * 64 + r32], a1 = abar[g * 64 + 32 + r32];
    bf16x8 bfr[4];
#pragma unroll
    for (int pt = 0; pt < 4; ++pt) bfr[pt] = *(const bf16x8*)(bmat + (32 * pt + r32) * 16 + 8 * hi);
    float c0r = 0.f, c0i = 0.f, c1r = 0.f, c1i = 0.f;
    if (FINAL) { const f32x2 v0 = E[((size_t)c * 32 + g) * 64 + r32], v1 = E[((size_t)c * 32 + g) * 64 + 32 + r32]; c0r = v0.x; c0i = v0.y; c1r = v1.x; c1i = v1.y; }
    const int tok0 = 64 * c + 16 * ((r32 >> 2) & 1) + 4 * (r32 >> 3) + (r32 & 3);
    const bf16x8 ufr0 = *(const bf16x8*)(proj + (size_t)tok0 * PW + C_S5U + 16 * g + 8 * hi), ufr1 = *(const bf16x8*)(proj + (size_t)(tok0 + 32) * PW + C_S5U + 16 * g + 8 * hi);
    bf16x8 dfr0 = ufr0, dfr1 = ufr1;
    if (FINAL) { dfr0 = *(const bf16x8*)(proj + (size_t)(64 * c + r32) * PW + C_S5U + 16 * g + 8 * hi); dfr1 = *(const bf16x8*)(proj + (size_t)(64 * c + 32 + r32) * PW + C_S5U + 16 * g + 8 * hi); }
#pragma unroll 1
    for (int tt = 0; tt < 2; ++tt) {
        const int t0 = 64 * c + 32 * tt;
        const bf16x8 ufr = tt ? ufr1 : ufr0;
        f32x16 acc[4];
#pragma unroll
        for (int pt = 0; pt < 4; ++pt) acc[pt] = __builtin_amdgcn_mfma_f32_32x32x16_bf16(ufr, bfr[pt], (f32x16){}, 0, 0, 0);
        scan16(acc[0], acc[2], a0.x, a0.y, c0r, c0i, hi);
        scan16(acc[1], acc[3], a1.x, a1.y, c1r, c1i, hi);
        if (FINAL) {
            LAS bf16* sw = sbuf + (16 * hi) * SB_PITCH + r32;
#pragma unroll
            for (int pt = 0; pt < 4; ++pt)
#pragma unroll
                for (int r = 0; r < 16; ++r) sw[r * SB_PITCH + 32 * pt] = (bf16)f2bf(acc[pt][r]);
            asm volatile("s_waitcnt lgkmcnt(0)" ::: "memory");
            f32x16 y = (f32x16){};
            const LAS bf16* sr = sbuf + r32 * SB_PITCH + 8 * hi; const bf16* cr_ = cmat + r32 * CM_PITCH + 8 * hi;
#pragma unroll
            for (int ks = 0; ks < 8; ++ks) { const bf16x8 afr = *(const LAS bf16x8*)(sr + 16 * ks); const bf16x8 cfr = *(const bf16x8*)(cr_ + 16 * ks);
                y = __builtin_amdgcn_mfma_f32_32x32x16_bf16(afr, cfr, y, 0, 0, 0); }
            { const bf16x8 afr = tt ? dfr1 : dfr0; const bf16x8 cfr = *(const bf16x8*)(cr_ + 128);
              y = __builtin_amdgcn_mfma_f32_32x32x16_bf16(afr, cfr, y, 0, 0, 0); }
            if (r32 < 16) { LAS bf16* yw = yg + (32 * tt + 4 * hi) * YG_PITCH + 16 * g + r32;
#pragma unroll
                for (int r = 0; r < 16; ++r) yw[((r & 3) + 8 * (r >> 2)) * YG_PITCH] = (bf16)f2bf(gelu_tanh(y[r])); }
            asm volatile("s_waitcnt lgkmcnt(0)" ::: "memory");
        }
    }
    if (!FINAL) { E[((size_t)c * 32 + g) * 64 + r32 + 32 * hi] = hi ? (f32x2){c1r, c1i} : (f32x2){c0r, c0i}; }
}

__device__ __forceinline__ void s5_carry_scan(const unsigned char* tab, const f32x2* E, f32x2* Sin, int g, int lane) {
    const f32x2 al = ((const f32x2*)(tab + S5T_AL))[g * 64 + lane];
    const f32x2* e0 = E + (size_t)g * 64 + lane; f32x2* s0 = Sin + (size_t)g * 64 + lane;
    float sr = 0.f, si = 0.f;
#pragma unroll 1
    for (int cb = 0; cb < 256; cb += 16) {
        f32x2 v[16];
#pragma unroll
        for (int i = 0; i < 16; ++i) v[i] = e0[(size_t)(cb + i) * 2048];
#pragma unroll
        for (int i = 0; i < 16; ++i) { s0[(size_t)(cb + i) * 2048] = (f32x2){sr, si}; const float t = al.x * sr - al.y * si + v[i].x; si = al.x * si + al.y * sr + v[i].y; sr = t; }
    }
}

__device__ __forceinline__ void s5_carry_scan_par(const unsigned char* tab, const f32x2* E, f32x2* Sin, int g, int lane, int w, LAS unsigned char* lds) {
    const f32x2 al = ((const f32x2*)(tab + S5T_AL))[g * 64 + lane];
    const f32x2* e0 = E + ((size_t)(32 * w) * 32 + g) * 64 + lane; f32x2* s0 = Sin + ((size_t)(32 * w) * 32 + g) * 64 + lane;
    f32x2 v[32];
#pragma unroll
    for (int i = 0; i < 32; ++i) v[i] = e0[(size_t)i * 2048];
    float sr = 0.f, si = 0.f;
#pragma unroll
    for (int i = 0; i < 32; ++i) { const float er = v[i].x, ei = v[i].y; v[i] = (f32x2){sr, si}; const float t = al.x * sr - al.y * si + er; si = al.x * si + al.y * sr + ei; sr = t; }
    LAS f32x2* tot = (LAS f32x2*)lds;
    tot[w * 64 + lane] = (f32x2){sr, si};
    float pr = al.x, pi = al.y;
#pragma unroll
    for (int k = 0; k < 5; ++k) { const float t = pr * pr - pi * pi; pi = 2.0f * pr * pi; pr = t; }
    __syncthreads();
    float cr = 0.f, ci = 0.f;
    for (int k = 0; k < w; ++k) { const f32x2 tk = tot[k * 64 + lane]; const float t = pr * cr - pi * ci + tk.x; ci = pr * ci + pi * cr + tk.y; cr = t; }
    float qr = 1.f, qi = 0.f;
#pragma unroll
    for (int i = 0; i < 32; ++i) { s0[(size_t)i * 2048] = (f32x2){v[i].x + qr * cr - qi * ci, v[i].y + qr * ci + qi * cr}; const float t = qr * al.x - qi * al.y; qi = qr * al.y + qi * al.x; qr = t; }
}

__device__ __forceinline__ void s5_final_chunk(const Frame& F, const unsigned char* tab, const bf16* __restrict__ proj, f32x2* E, const bf16* __restrict__ wglu_t, const float* mixg, bf16* mix, int c) {
    int lane = lane_id(); asm volatile("" : "+v"(lane));
    const int w = F.wave, r32 = lane & 31, hi = lane >> 5;
    LAS bf16* yg = (LAS bf16*)(F.lds + LDS_YG); LAS bf16* sbuf = (LAS bf16*)(F.lds + LDS_SB + w * SB_BYTES); LAS float* red = (LAS float*)(F.lds + LDS_RED);
#pragma unroll 1
    for (int gi = 0; gi < 4; ++gi) s5_group<true>(lane, tab, proj, E, c, 4 * w + gi, sbuf, yg);
    __syncthreads();
    f32x16 z[2][2];
#pragma unroll
    for (int a = 0; a < 2; ++a)
#pragma unroll
        for (int b = 0; b < 2; ++b) z[a][b] = (f32x16){};
    const int n0 = 64 * w;
    const bf16* wr_ = wglu_t + (size_t)(n0 + r32) * GW + 8 * hi; const LAS bf16* yr_ = yg + r32 * YG_PITCH + 8 * hi;
#pragma unroll 8
    for (int ks = 0; ks < 32; ++ks) {
        bf16x8 afr[2], bfr[2];
#pragma unroll
        for (int nt = 0; nt < 2; ++nt) afr[nt] = *(const bf16x8*)(wr_ + (size_t)(32 * nt) * GW + 16 * ks);
#pragma unroll
        for (int tt = 0; tt < 2; ++tt) bfr[tt] = *(const LAS bf16x8*)(yr_ + (32 * tt) * YG_PITCH + 16 * ks);
#pragma unroll
        for (int nt = 0; nt < 2; ++nt)
#pragma unroll
            for (int tt = 0; tt < 2; ++tt) z[nt][tt] = __builtin_amdgcn_mfma_f32_32x32x16_bf16(afr[nt], bfr[tt], z[nt][tt], 0, 0, 0);
    }
#pragma unroll
    for (int tt = 0; tt < 2; ++tt) { const int t = 32 * tt + r32; float ss = 0.f;
#pragma unroll
        for (int nt = 0; nt < 2; ++nt)
#pragma unroll
            for (int rq = 0; rq < 4; ++rq) { const int n4 = n0 + 32 * nt + 8 * rq + 4 * hi; const u32x2 yv = *(const LAS u32x2*)(yg + t * YG_PITCH + n4);
                const float y0 = bflo(yv.x), y1 = bfhi(yv.x), y2 = bflo(yv.y), y3 = bfhi(yv.y);
                float v;
                v = y0 * sigmoidf_(z[nt][tt][4 * rq + 0]); z[nt][tt][4 * rq + 0] = v; ss += v * v;
                v = y1 * sigmoidf_(z[nt][tt][4 * rq + 1]); z[nt][tt][4 * rq + 1] = v; ss += v * v;
                v = y2 * sigmoidf_(z[nt][tt][4 * rq + 2]); z[nt][tt][4 * rq + 2] = v; ss += v * v;
                v = y3 * sigmoidf_(z[nt][tt][4 * rq + 3]); z[nt][tt][4 * rq + 3] = v; ss += v * v; }
        ss = swap_sum(ss);
        if (hi == 0) red[w * 64 + t] = ss; }
    __syncthreads();
#pragma unroll
    for (int tt = 0; tt < 2; ++tt) { const int t = 32 * tt + r32; float tot = 0.f;
#pragma unroll
        for (int ww = 0; ww < 8; ++ww) tot += red[ww * 64 + t];
        const float rstd = rsqrtf(tot * (1.0f / 512.0f) + EPS);
        bf16* orow = mix + (size_t)(64 * c + t) * D;
#pragma unroll
        for (int nt = 0; nt < 2; ++nt)
#pragma unroll
            for (int rq = 0; rq < 4; ++rq) { const int n4 = n0 + 32 * nt + 8 * rq + 4 * hi; const f32x4 gq = *(const f32x4*)(mixg + n4);
                u32x2 wv; wv.x = gm::cvt_pk_bf16(z[nt][tt][4 * rq + 0] * rstd * gq.x, z[nt][tt][4 * rq + 1] * rstd * gq.y); wv.y = gm::cvt_pk_bf16(z[nt][tt][4 * rq + 2] * rstd * gq.z, z[nt][tt][4 * rq + 3] * rstd * gq.w);
                *(u32x2*)(orow + n4) = wv; } }
    __syncthreads();
}
}

__device__ __forceinline__ void conv_row(const Frame& F, const bf16* __restrict__ proj, const float* cw, const float* mixg, bf16* mix, int t) {
    int lane = lane_id(); asm volatile("" : "+v"(lane));
    const int c0 = 8 * lane;
    float z[3][8];
#pragma unroll
    for (int k = 0; k < 3; ++k) { const int tt = t - 2 + k;
        if (tt >= 0) { const u32x4 a = *(const u32x4*)(proj + (size_t)tt * PW + C_CC + c0), b = *(const u32x4*)(proj + (size_t)tt * PW + C_CH + c0);
            z[k][0] = bflo(a.x) * bflo(b.x); z[k][1] = bfhi(a.x) * bfhi(b.x); z[k][2] = bflo(a.y) * bflo(b.y); z[k][3] = bfhi(a.y) * bfhi(b.y);
            z[k][4] = bflo(a.z) * bflo(b.z); z[k][5] = bfhi(a.z) * bfhi(b.z); z[k][6] = bflo(a.w) * bflo(b.w); z[k][7] = bfhi(a.w) * bfhi(b.w); }
        else {
#pragma unroll
            for (int j = 0; j < 8; ++j) z[k][j] = 0.f; } }
    const u32x4 bb = *(const u32x4*)(proj + (size_t)t * PW + C_CB + c0);
    const float bv[8] = {bflo(bb.x), bfhi(bb.x), bflo(bb.y), bfhi(bb.y), bflo(bb.z), bfhi(bb.z), bflo(bb.w), bfhi(bb.w)};
    float o[8]; float ss = 0.f;
#pragma unroll
    for (int j = 0; j < 8; ++j) { const float cv = cw[c0 + j] * z[0][j] + cw[GW + c0 + j] * z[1][j] + cw[2 * GW + c0 + j] * z[2][j]; o[j] = bv[j] * cv; ss += o[j] * o[j]; }
    ss = wave_sum(ss);
    const float rstd = rsqrtf(ss * (1.0f / 512.0f) + EPS);
    u32x4 wv; wv.x = pk2(o[0] * rstd * mixg[c0], o[1] * rstd * mixg[c0 + 1]); wv.y = pk2(o[2] * rstd * mixg[c0 + 2], o[3] * rstd * mixg[c0 + 3]);
    wv.z = pk2(o[4] * rstd * mixg[c0 + 4], o[5] * rstd * mixg[c0 + 5]); wv.w = pk2(o[6] * rstd * mixg[c0 + 6], o[7] * rstd * mixg[c0 + 7]);
    *(u32x4*)(mix + (size_t)t * D + 512 + c0) = wv;
}

namespace sgu {
constexpr int LDS_V = 0, LDS_RED = 131072, LDS_SGU_BYTES = LDS_RED + 4 * 128 * 4;
static_assert(LDS_SGU_BYTES <= LDS_MISC, "sgu lds");
__device__ __forceinline__ void sgu_block(const Frame& F, const bf16* __restrict__ proj, const float* lng, const float* lnb, const bf16* __restrict__ wsb, const float* sb, const float* mixg, bf16* mix, int blk) {
    int lane = lane_id(); asm volatile("" : "+v"(lane));
    LAS unsigned char* lds = F.lds; LAS float* red = (LAS float*)(lds + LDS_RED);
    const int w = F.wave, r32 = lane & 31, hi = lane >> 5, t0 = 128 * blk;
    u32x4 araw[16];
#pragma unroll
    for (int jj = 0; jj < 16; ++jj) araw[jj] = *(const u32x4*)(proj + (size_t)(t0 + w + 8 * jj) * PW + C_SV + 8 * lane);
#pragma unroll
    for (int jj = 0; jj < 16; ++jj) { const int j = w + 8 * jj;
        const int c0 = 8 * lane; const u32x4 a = araw[jj];
        float v[8] = {bflo(a.x), bfhi(a.x), bflo(a.y), bfhi(a.y), bflo(a.z), bfhi(a.z), bflo(a.w), bfhi(a.w)};
        float s = 0.f;
#pragma unroll
        for (int q = 0; q < 8; ++q) { v[q] = gelu_tanh(v[q]); s += v[q]; }
        const float mean = wave_sum(s) * (1.0f / 512.0f); float s2 = 0.f;
#pragma unroll
        for (int q = 0; q < 8; ++q) { v[q] -= mean; s2 += v[q] * v[q]; }
        const float rstd = rsqrtf(wave_sum(s2) * (1.0f / 512.0f) + EPS);
#pragma unroll
        for (int q = 0; q < 8; ++q) v[q] = v[q] * rstd * lng[c0 + q] + lnb[c0 + q];
        u32x4 o; o.x = pk2(v[0], v[1]); o.y = pk2(v[2], v[3]); o.z = pk2(v[4], v[5]); o.w = pk2(v[6], v[7]);
        *(LAS u32x4*)(lds + LDS_V + (lane >> 2) * 8192 + j * 64 + (lane & 3) * 16) = o;
    }
    __syncthreads();
    const int h = w >> 1, ih = w & 1;
    f32x16 acc[4][2];
#pragma unroll
    for (int ct = 0; ct < 4; ++ct)
#pragma unroll
        for (int it = 0; it < 2; ++it) acc[ct][it] = (f32x16){};
    const LAS unsigned char* vb = lds + LDS_V + (4 * h) * 8192 + (4 * hi + ((lane & 15) >> 2)) * 64 + ((lane >> 4) & 1) * 32 + (lane & 3) * 8;
    const bf16* wrow = wsb + ((size_t)h * 128 + 64 * ih + r32) * 128 + 4 * hi;
    const int nks = ih ? 8 : 4;
#pragma unroll 1
    for (int ks = 0; ks < nks; ++ks) {
        bf16x8 bfr[2];
#pragma unroll
        for (int it = 0; it < 2; ++it) { const u32x2 b0 = *(const u32x2*)(wrow + (32 * it) * 128 + 16 * ks), b1 = *(const u32x2*)(wrow + (32 * it) * 128 + 16 * ks + 8);
            bfr[it] = __builtin_bit_cast(bf16x8, (u32x4){b0.x, b0.y, b1.x, b1.y}); }
#pragma unroll
        for (int ct = 0; ct < 4; ++ct) { const s16x4 lo = at::vtr(vb + ct * 8192 + (16 * ks) * 64), hh = at::vtr(vb + ct * 8192 + (16 * ks + 8) * 64);
            const bf16x8 afr = (bf16x8){lo[0], lo[1], lo[2], lo[3], hh[0], hh[1], hh[2], hh[3]};
#pragma unroll
            for (int it = 0; it < 2; ++it) acc[ct][it] = __builtin_amdgcn_mfma_f32_32x32x16_bf16(afr, bfr[it], acc[ct][it], 0, 0, 0); }
    }
#pragma unroll
    for (int it = 0; it < 2; ++it) { const int i = 64 * ih + 32 * it + r32; const float bsv = sb[h * 128 + i]; float ss = 0.f;
        const bf16* srow = proj + (size_t)(t0 + i) * PW + C_SU + h * 128 + 4 * hi;
#pragma unroll
        for (int ct = 0; ct < 4; ++ct)
#pragma unroll
            for (int rq = 0; rq < 4; ++rq) { const u32x2 uv = *(const u32x2*)(srow + 32 * ct + 8 * rq);
                float v;
                v = gelu_tanh(bflo(uv.x)) * (acc[ct][it][4 * rq + 0] + bsv); acc[ct][it][4 * rq + 0] = v; ss += v * v;
                v = gelu_tanh(bfhi(uv.x)) * (acc[ct][it][4 * rq + 1] + bsv); acc[ct][it][4 * rq + 1] = v; ss += v * v;
                v = gelu_tanh(bflo(uv.y)) * (acc[ct][it][4 * rq + 2] + bsv); acc[ct][it][4 * rq + 2] = v; ss += v * v;
                v = gelu_tanh(bfhi(uv.y)) * (acc[ct][it][4 * rq + 3] + bsv); acc[ct][it][4 * rq + 3] = v; ss += v * v; }
        ss = swap_sum(ss);
        if (hi == 0) red[h * 128 + i] = ss; }
    __syncthreads();
#pragma unroll
    for (int it = 0; it < 2; ++it) { const int i = 64 * ih + 32 * it + r32;
        const float tot = (red[i] + red[128 + i]) + (red[256 + i] + red[384 + i]);
        const float rstd = rsqrtf(tot * (1.0f / 512.0f) + EPS);
        bf16* orow = mix + (size_t)(t0 + i) * D + 1024 + h * 128 + 4 * hi; const float* gp = mixg + h * 128 + 4 * hi;
#pragma unroll
        for (int ct = 0; ct < 4; ++ct)
#pragma unroll
            for (int rq = 0; rq < 4; ++rq) { const f32x4 gq = *(const f32x4*)(gp + 32 * ct + 8 * rq);
                u32x2 wv; wv.x = gm::cvt_pk_bf16(acc[ct][it][4 * rq + 0] * rstd * gq.x, acc[ct][it][4 * rq + 1] * rstd * gq.y); wv.y = gm::cvt_pk_bf16(acc[ct][it][4 * rq + 2] * rstd * gq.z, acc[ct][it][4 * rq + 3] * rstd * gq.w);
                *(u32x2*)(orow + 32 * ct + 8 * rq) = wv; } }
    __syncthreads();
}
}

namespace rt {
constexpr int LDS_PART = 0, LDS_SEL = 32768, LDS_SC = LDS_SEL + 64 * 65 * 4, LDS_E = LDS_SC + 64 * 65 * 4, LDS_R = LDS_E + 64 * 8 * 4;
__device__ __forceinline__ void ln_router_tile(const Frame& F, const bf16* yf, const float* g1, const float* b1, bf16* x1b, bf16* x1l, unsigned char* x1q, const bf16* __restrict__ rthi, const bf16* __restrict__ rtlo,
                                               const float* rbias, int* selE, float* selW, int* selR, int* cnt, int tile) {
    int tid = F.wave * 64 + lane_id(); asm volatile("" : "+v"(tid));
    LAS unsigned char* lds = F.lds; const int lane = tid & 63, w = F.wave, r32 = lane & 31, hi = lane >> 5, t0 = 64 * tile;
    for (int rp1 = 0; rp1 < 1 + ((REPMASK >> 15) & 1); ++rp1)
#pragma unroll 1
    for (int rq = 0; rq < 8; rq += 4) {
    u32x2 yraw[4][8];
#pragma unroll
    for (int r4 = 0; r4 < 4; ++r4) { const u32x2* yr = (const u32x2*)(yf + (size_t)(t0 + 8 * w + rq + r4) * D) + lane;
#pragma unroll
        for (int j = 0; j < 8; ++j) yraw[r4][j] = __builtin_nontemporal_load(yr + 64 * j); }
#pragma unroll
    for (int r4 = 0; r4 < 4; ++r4) {
        const int t = t0 + 8 * w + rq + r4;
        f32x4 v[8]; float s = 0.f;
#pragma unroll
        for (int j = 0; j < 8; ++j) { const u32x2 y = yraw[r4][j]; v[j] = (f32x4){bflo(y.x), bfhi(y.x), bflo(y.y), bfhi(y.y)}; s += (v[j].x + v[j].y) + (v[j].z + v[j].w); }
        const float mean = wave_sum(s) * (1.0f / D); float s2 = 0.f;
#pragma unroll
        for (int j = 0; j < 8; ++j) { v[j] = v[j] - mean; s2 += (v[j].x * v[j].x + v[j].y * v[j].y) + (v[j].z * v[j].z + v[j].w * v[j].w); }
        const float rstd = rsqrtf(wave_sum(s2) * (1.0f / D) + EPS);
#pragma unroll
        for (int j = 0; j < 8; ++j) { const int c = 4 * lane + 256 * j; const f32x4 gg = *(const f32x4*)(g1 + c), bb = *(const f32x4*)(b1 + c);
            const f32x4 o = v[j] * rstd * gg + bb;
            u32x2 wh; wh.x = pk2(o.x, o.y); wh.y = pk2(o.z, o.w); *(u32x2*)(x1b + (size_t)t * D + c) = wh;
            u32x2 wl; wl.x = pk2(o.x - bflo(wh.x), o.y - bfhi(wh.x)); wl.y = pk2(o.z - bflo(wh.y), o.w - bfhi(wh.y)); *(u32x2*)(x1l + (size_t)t * D + c) = wl;
            if (x1q) *(unsigned*)(x1q + (size_t)t * D + c) = pk4_fp8(o.x, o.y, o.z, o.w); }
    }
    }
    __threadfence_block();
    __syncthreads();
    for (int rp2 = 0; rp2 < 1 + ((REPMASK >> 16) & 1); ++rp2)
    { const int tt = w >> 2, et = (w >> 1) & 1, kh = w & 1;
      asm volatile("" ::: "memory");
      f32x16 acc = (f32x16){};
      const int mm = w >> 1; const bf16* mbase = (mm == 0) ? x1b + (size_t)t0 * D : (mm == 1) ? x1l + (size_t)t0 * D : (mm == 2) ? rthi : rtlo;
      const bf16* gp[4];
#pragma unroll
      for (int i = 0; i < 4; ++i) { const int row = 32 * (w & 1) + 8 * i + (lane >> 3); gp[i] = mbase + (size_t)row * D + 8 * ((lane & 7) ^ ((row >> 1) & 7)); }
      const unsigned dbase = (unsigned)mm * 8192u + (unsigned)(w & 1) * 4096u;
#define RT_DMA(c) do { _Pragma("unroll") for (int i = 0; i < 4; ++i) \
          __builtin_amdgcn_global_load_lds((const unsigned*)(gp[i] + 64 * (c)), (LAS unsigned*)(lds + ((c) & 3) * 32768 + dbase + i * 1024), 16, 0, 0); } while (0)
      RT_DMA(0); RT_DMA(1); RT_DMA(2);
      const int ra = 32 * tt + r32, rb = 32 * et + r32, sa = (ra >> 1) & 7, sb = (rb >> 1) & 7;
#pragma unroll 1
      for (int c = 0; c < 32; ++c) {
          if (c < 30) asm volatile("s_waitcnt vmcnt(8)" ::: "memory"); else if (c == 30) asm volatile("s_waitcnt vmcnt(4)" ::: "memory"); else asm volatile("s_waitcnt vmcnt(0)" ::: "memory");
          asm volatile("s_waitcnt lgkmcnt(0)" ::: "memory");
          __builtin_amdgcn_s_barrier();
          asm volatile("" ::: "memory"); __builtin_amdgcn_sched_barrier(0);
          if (c + 3 < 32) RT_DMA(c + 3);
          const LAS unsigned char* bb = lds + (c & 3) * 32768;
#pragma unroll
          for (int s2 = 0; s2 < 2; ++s2) { const int ch = 2 * (2 * kh + s2) + hi;
              const bf16x8 a_h = *(const LAS bf16x8*)(bb + ra * 128 + ((ch ^ sa) * 16)), a_l = *(const LAS bf16x8*)(bb + 8192 + ra * 128 + ((ch ^ sa) * 16));
              const bf16x8 b_h = *(const LAS bf16x8*)(bb + 16384 + rb * 128 + ((ch ^ sb) * 16)), b_l = *(const LAS bf16x8*)(bb + 24576 + rb * 128 + ((ch ^ sb) * 16));
              acc = __builtin_amdgcn_mfma_f32_32x32x16_bf16(a_l, b_h, acc, 0, 0, 0); acc = __builtin_amdgcn_mfma_f32_32x32x16_bf16(a_h, b_l, acc, 0, 0, 0); acc = __builtin_amdgcn_mfma_f32_32x32x16_bf16(a_h, b_h, acc, 0, 0, 0); }
          asm volatile("" ::: "memory");
      }
#undef RT_DMA
      asm volatile("s_waitcnt lgkmcnt(0)" ::: "memory");
      __builtin_amdgcn_s_barrier();
      asm volatile("" ::: "memory");
      LAS float* part = (LAS float*)(lds + LDS_PART) + kh * 4096;
#pragma unroll
      for (int r = 0; r < 16; ++r) part[(32 * tt + crow(r, hi)) * 64 + 32 * et + r32] = acc[r];
    }
    __syncthreads();
    LAS float* sel = (LAS float*)(lds + LDS_SEL); LAS float* sc = (LAS float*)(lds + LDS_SC); LAS int* sE = (LAS int*)(lds + LDS_E); LAS int* sR = (LAS int*)(lds + LDS_R);
    { const LAS float* part = (const LAS float*)(lds + LDS_PART);
      for (int i = tid; i < 4096; i += NTHR) { const int t = i >> 6, e = i & 63; const float s = sigmoid_div(part[i] + part[4096 + i]); sc[t * 65 + e] = s; sel[t * 65 + e] = s + rbias[e]; } }
    __syncthreads();
    LAS unsigned* mk = (LAS unsigned*)(lds + LDS_R + 2048);
    if (tid < 128) mk[tid] = 0u;
    {
        const int tl = lane >> 3, g = lane & 7, t = 8 * w + tl; const LAS float* sl = sel + t * 65 + 8 * g;
        float v[8];
#pragma unroll
        for (int q = 0; q < 8; ++q) v[q] = sl[q];
        float m1 = -INFINITY, m2 = -INFINITY;
#pragma unroll
        for (int q = 0; q < 8; ++q) { if (v[q] > m1) { m2 = m1; m1 = v[q]; } else if (v[q] > m2) m2 = v[q]; }
        const float gs = m1 + m2; int rank = 0;
#pragma unroll
        for (int d = 1; d < 8; ++d) { const int og = (g + d) & 7; const float o = shfl_xor_l(gs, lane, g ^ og); rank += (o > gs || (o == gs && og < g)) ? 1 : 0; }
        if (rank >= 4) {
#pragma unroll
            for (int q = 0; q < 8; ++q) v[q] = -INFINITY; }
        float wsum = 0.f, myw = 0.f; int mye = 0;
#pragma unroll
        for (int k = 0; k < 8; ++k) {
            float bv = v[0]; int bi = 8 * g;
#pragma unroll
            for (int q = 1; q < 8; ++q) if (v[q] > bv) { bv = v[q]; bi = 8 * g + q; }
#pragma unroll
            for (int x = 1; x < 8; x <<= 1) { const float ov = shfl_xor_l(bv, lane, x); const int oi = __builtin_bit_cast(int, shfl_xor_l(__builtin_bit_cast(float, bi), lane, x));
                if (ov > bv || (ov == bv && oi < bi)) { bv = ov; bi = oi; } }
#pragma unroll
            for (int q = 0; q < 8; ++q) if (bi == 8 * g + q) v[q] = -INFINITY;
            const float sv = sc[t * 65 + bi]; wsum += sv;
            if (g == k) { myw = sv; mye = bi; }
        }
        const float sc_ = 2.5f / (wsum + 1e-20f);
        sE[t * 8 + g] = mye; selE[(size_t)(t0 + t) * 8 + g] = mye; selW[(size_t)(t0 + t) * 8 + g] = myw * sc_;
    }
    __syncthreads();
    { const int t = tid >> 3; const int e = sE[tid]; __hip_atomic_fetch_or(mk + 2 * e + (t >> 5), 1u << (t & 31), __ATOMIC_RELAXED, __HIP_MEMORY_SCOPE_WORKGROUP); }
    __syncthreads();
    { const int t = tid >> 3; const int e = sE[tid]; const unsigned lo_ = mk[2 * e], hi2 = mk[2 * e + 1];
      const int rk = (t < 32) ? __builtin_popcount(lo_ & ((1u << t) - 1u)) : __builtin_popcount(lo_) + __builtin_popcount(hi2 & ((1u << (t - 32)) - 1u));
      selR[(size_t)t0 * 8 + tid] = rk; }
    if (tid < 64) cnt[tile * 64 + tid] = __builtin_popcount(mk[2 * tid]) + __builtin_popcount(mk[2 * tid + 1]);
    __syncthreads();
}
}

namespace sc {
__device__ __forceinline__ void scatter_tile(const Frame& F, const int* cnt, const int* selE, const int* selR, int* rowtok, int* slot, int* etab, int tile) {
    LAS int* ps = (LAS int*)F.lds;
    int tid = F.wave * 64 + lane_id(); asm volatile("" : "+v"(tid));
    const int e = tid & 63, q = tid >> 6;
    { int tot = 0, off = 0; int cv[32];
#pragma unroll
      for (int i = 0; i < 32; ++i) cv[i] = cnt[(q + 8 * i) * 64 + e];
#pragma unroll
      for (int i = 0; i < 32; ++i) { tot += cv[i]; off += (q + 8 * i < tile) ? cv[i] : 0; }
      ps[q * 64 + e] = tot; ps[512 + q * 64 + e] = off; }
    __syncthreads();
    if (tid < 64) { int tot = 0, off = 0;
#pragma unroll
        for (int k = 0; k < 8; ++k) { tot += ps[k * 64 + tid]; off += ps[512 + k * 64 + tid]; }
        ps[1024 + tid] = tot; ps[1088 + tid] = off; }
    __syncthreads();
    if (tid == 0) { int tp = 0;
        for (int k = 0; k < 64; ++k) { ps[1152 + k] = tp; tp += (ps[1024 + k] + 255) >> 8; }
        ps[1152 + 64] = tp; ps[1152 + 65] = tp + 64; }
    __syncthreads();
    if (tile == 0 && tid < 66) etab[tid] = ps[1152 + tid];
    { const int t = tid >> 3, k = tid & 7, tg = tile * 64 + t; const int ee = selE[(size_t)tg * 8 + k]; const int pos = ps[1152 + ee] * 256 + ps[1088 + ee] + selR[(size_t)tg * 8 + k];
      rowtok[pos] = tg; slot[(size_t)tg * 8 + k] = pos; }
    if (tid < 64) rowtok[ps[1152 + 64] * 256 + tile * 64 + tid] = tile * 64 + tid;
    if (tile < 64) { const int b0 = ps[1152 + tile] * 256 + ps[1024 + tile], b1 = ps[1152 + tile + 1] * 256;
        for (int p = b0 + tid; p < b1; p += NTHR) rowtok[p] = 0; }
    __syncthreads();
}
}

template <bool YS8>
__device__ __forceinline__ void combine_row(const Frame& F, const bf16* __restrict__ ys, const int* slot, const float* selW, const bf16* x1b, const float* g2, const float* b2, float* xout, bf16* xb, int sh_base, int t, bool last) {
    int lane = lane_id(); asm volatile("" : "+v"(lane));
    LAS float* vs = (LAS float*)(F.lds + F.wave * 8192) + lane * 8;
    constexpr int YB = YS8 ? 1 : 2;
    unsigned ro[9]; float wk[9];
#pragma unroll
    for (int k = 0; k < 8; ++k) { ro[k] = (unsigned)slot[(size_t)t * 8 + k] * (unsigned)(D * YB); wk[k] = selW[(size_t)t * 8 + k] * (YS8 ? 1.0f / YS8SCALE : 1.0f); }
    ro[8] = (unsigned)(sh_base + t) * (unsigned)(D * YB); wk[8] = YS8 ? 1.0f / YS8SCALE : 1.0f;
    const char* ysb = (const char*)ys + 8 * YB * lane; const bf16* xr = x1b + (size_t)t * D + 8 * lane;
    float s = 0.f;
    u32x2 y8[YS8 ? 4 : 1][9]; u32x4 xq4[YS8 ? 4 : 1];
    if constexpr (YS8) {
#pragma unroll
        for (int j = 0; j < 4; ++j) {
#pragma unroll
            for (int k = 0; k < 9; ++k) y8[j][k] = __builtin_nontemporal_load((const u32x2*)(ysb + ro[k] + 512 * j));
            xq4[j] = __builtin_nontemporal_load((const u32x4*)(xr + 512 * j)); }
    }
#pragma unroll
    for (int j = 0; j < 4; ++j) {
        float a[8] = {0.f, 0.f, 0.f, 0.f, 0.f, 0.f, 0.f, 0.f};
        if constexpr (YS8) {
            const u32x2 (&y)[9] = y8[j];
#pragma unroll
            for (int k = 0; k < 9; ++k) { const f32x2 q0 = __builtin_amdgcn_cvt_pk_f32_fp8((int)y[k].x, false), q1 = __builtin_amdgcn_cvt_pk_f32_fp8((int)y[k].x, true), q2 = __builtin_amdgcn_cvt_pk_f32_fp8((int)y[k].y, false), q3 = __builtin_amdgcn_cvt_pk_f32_fp8((int)y[k].y, true);
                a[0] += q0.x * wk[k]; a[1] += q0.y * wk[k]; a[2] += q1.x * wk[k]; a[3] += q1.y * wk[k]; a[4] += q2.x * wk[k]; a[5] += q2.y * wk[k]; a[6] += q3.x * wk[k]; a[7] += q3.y * wk[k]; }
        } else {
            u32x4 y[9];
#pragma unroll
            for (int k = 0; k < 9; ++k) y[k] = *(const u32x4*)(ysb + ro[k] + 1024 * j);
#pragma unroll
            for (int k = 0; k < 9; ++k) { a[0] += bflo(y[k].x) * wk[k]; a[1] += bfhi(y[k].x) * wk[k]; a[2] += bflo(y[k].y) * wk[k]; a[3] += bfhi(y[k].y) * wk[k];
                a[4] += bflo(y[k].z) * wk[k]; a[5] += bfhi(y[k].z) * wk[k]; a[6] += bflo(y[k].w) * wk[k]; a[7] += bfhi(y[k].w) * wk[k]; }
        }
        u32x4 xq; if constexpr (YS8) xq = xq4[j]; else xq = *(const u32x4*)(xr + 512 * j);
        const f32x4 xa = (f32x4){bflo(xq.x), bfhi(xq.x), bflo(xq.y), bfhi(xq.y)}, xb4 = (f32x4){bflo(xq.z), bfhi(xq.z), bflo(xq.w), bfhi(xq.w)};
        const f32x4 va = xa * ALPHA + (f32x4){a[0], a[1], a[2], a[3]}, vb = xb4 * ALPHA + (f32x4){a[4], a[5], a[6], a[7]};
        *(LAS f32x4*)(vs + 512 * j) = va; *(LAS f32x4*)(vs + 512 * j + 4) = vb;
        s += ((va.x + va.y) + (va.z + va.w)) + ((vb.x + vb.y) + (vb.z + vb.w)); }
    const float mean = wave_sum(s) * (1.0f / D); float s2 = 0.f;
#pragma unroll
    for (int j = 0; j < 4; ++j) { const f32x4 va = *(const LAS f32x4*)(vs + 512 * j) - mean, vb = *(const LAS f32x4*)(vs + 512 * j + 4) - mean;
        s2 += ((va.x * va.x + va.y * va.y) + (va.z * va.z + va.w * va.w)) + ((vb.x * vb.x + vb.y * vb.y) + (vb.z * vb.z + vb.w * vb.w)); }
    const float rstd = rsqrtf(wave_sum(s2) * (1.0f / D) + EPS);
    float* orow = xout + (size_t)t * D + 8 * lane; bf16* brow = xb + (size_t)t * D + 8 * lane;
#pragma unroll 1
    for (int j = 0; j < 4; ++j) { const int c = 8 * lane + 512 * j;
        const f32x4 ga = *(const f32x4*)(g2 + c), gb = *(const f32x4*)(g2 + c + 4), ba = *(const f32x4*)(b2 + c), bb = *(const f32x4*)(b2 + c + 4);
        const f32x4 oa = (*(const LAS f32x4*)(vs + 512 * j) - mean) * rstd * ga + ba, ob = (*(const LAS f32x4*)(vs + 512 * j + 4) - mean) * rstd * gb + bb;
        if (last) { *(f32x4*)(orow + 512 * j) = oa; *(f32x4*)(orow + 512 * j + 4) = ob; }
        u32x4 wv; wv.x = pk2(oa.x, oa.y); wv.y = pk2(oa.z, oa.w); wv.z = pk2(ob.x, ob.y); wv.w = pk2(ob.z, ob.w); *(u32x4*)(brow + 512 * j) = wv; }
}

constexpr int NPPL = 10, NPH = 1 + NPPL * DEPTH, CONV_LO = 8192;
__global__ void __launch_bounds__(NTHR, 2) fwd(Args args) {
    extern __shared__ __attribute__((aligned(16))) unsigned char lds_raw[];
    Frame F;
    F.lds = (LAS unsigned char*)lds_raw;
    F.wave = __builtin_amdgcn_readfirstlane(threadIdx.x >> 6);
    F.G = gridDim.x; { const int bx = blockIdx.x; F.vcu = (F.G % 8 == 0) ? (bx % 8) * (F.G / 8) + bx / 8 : bx; }
    volatile LAS unsigned* MISC = (volatile LAS unsigned*)(F.lds + LDS_MISC);
    if (threadIdx.x < 64) MISC[threadIdx.x] = 0u;
    __syncthreads();
    typedef const __attribute__((address_space(4))) Args* KArgs;
#define PHASE_ENV() KArgs ka = (KArgs)__builtin_amdgcn_kernarg_segment_ptr(); asm volatile("" : "+s"(ka)); unsigned char* const ws = ka->ws; (void)ws; \
    Frame Fp; Fp.lds = F.lds; { int w_ = F.wave, v_ = F.vcu, g_ = F.G; asm volatile("" : "+s"(w_), "+s"(v_), "+s"(g_)); Fp.wave = w_; Fp.vcu = v_; Fp.G = g_; } \
    const int gw = Fp.vcu * NWAVES + Fp.wave, NGW = Fp.G * NWAVES; (void)gw; (void)NGW
#define XB_   ((bf16*)(ws + WS_XB))
#define PROJ_ ((bf16*)(ws + WS_PROJ))
#define MIX_  ((bf16*)(ws + WS_MIX))
#define YFB_  ((bf16*)(ws + WS_YF))
#define X1Q_  ((unsigned char*)(ws + WS_X1F))
#define X1B_  ((bf16*)(ws + WS_X1B))
#define X1L_  ((bf16*)(ws + WS_X1L))
#define HB_   ((bf16*)(ws + WS_H))
#define YS_   ((bf16*)(ws + WS_YS))
#define ETAB_ ((int*)(ws + WS_ETAB))
#define CNT_  ((int*)(ws + WS_CNT))
#define SELE_ ((int*)(ws + WS_SELE))
#define SELW_ ((float*)(ws + WS_SELW))
#define SELR_ ((int*)(ws + WS_SELR))
#define SLOT_ ((int*)(ws + WS_SLOT))
#define ROWTOK_ ((int*)(ws + WS_ROWTOK))
#define S5E_  ((f32x2*)(ws + WS_S5E))
#define S5IN_ ((f32x2*)(ws + WS_S5IN))
#define S5TAB_ (ws + WS_S5TAB + (size_t)l * S5TAB_STRIDE)
#define MIXG_ (ka->in[3] + l * 1536)
#if MK_ONE_LAUNCH
    XcdBarrier bar = xcd_barrier_post((unsigned*)(args.ws + WS_CTL) + CW_BAR, MISC + 8);
#define GRID_BAR() do { xcd_barrier(bar); if ((REPMASK >> 17) & 1) xcd_barrier(bar); } while (0)
#else
#define GRID_BAR() do { } while (0)
#endif
    const int lo = args.ph_lo, hi_ = args.ph_hi;
#ifndef PHMASK
#define PHMASK 0x7fff
#endif
#define EN(j) (((PHMASK) >> (j)) & 1)
#ifndef REPMASK
#define REPMASK 0
#endif
#define REP(j) for (int rep_ = 0; rep_ < 1 + (((REPMASK) >> (j)) & 1); ++rep_)
#define IN(k) (lo <= (k) && (k) < hi_)
#define BOTH(k) (IN(k) && IN((k) + 1))

    if (EN(0) && IN(0)) { REP(0) p0_prologue(F, args); if (BOTH(0)) GRID_BAR(); }

    for (int l = 0; l < DEPTH; ++l) {
        const int pb = 1 + NPPL * l;
        if (EN(1) && IN(pb + 0)) {
            PHASE_ENV(); int bx_ = blockIdx.x; asm volatile("" : "+s"(bx_));
            gm::Gemm g{XB_, (const bf16*)(ws + WS_WIN) + (size_t)l * PW * D, D, nullptr, 0};
            gm::DenseOrder S; gm::EpiBf16 E{PROJ_, PW, 1.0f};
            const bool ovl = (l == 0 && Fp.G == 256);
            if (ovl) S.init(T, C_Q, 128, bx_ - 128); else S.init(T, C_Q, Fp.G, bx_);
            if (ovl && bx_ < 128) convert_items(Fp, TI_WIN, TI_TOTAL - TI_DEFER, bx_ * NWAVES + Fp.wave, 128 * NWAVES);
            else { REP(1) gm::gemm_phase<gm::EpiBf16, gm::DenseOrder, false>(Fp.lds, Fp.wave, g, S, E);
                if (ovl) {
                    gm::Gemm g2{XB_, (const bf16*)(ws + WS_WIN) + (size_t)l * PW * D + (size_t)C_Q * D, D, nullptr, 0};
                    gm::DenseOrder S2; S2.init(T, PW - C_Q, 128, bx_ - 128);
                    gm::EpiBf16 E2{PROJ_ + C_Q, PW, 1.0f};
                    gm::gemm_phase<gm::EpiBf16, gm::DenseOrder, false>(Fp.lds, Fp.wave, g2, S2, E2); } }
            if (BOTH(pb + 0)) GRID_BAR();
        }
        if (EN(2) && IN(pb + 1)) {
            PHASE_ENV(); int bx_ = blockIdx.x; asm volatile("" : "+s"(bx_));
            const bool l0 = (l == 0 && Fp.G == 256);
            if (EN(1) && !l0) {
                gm::Gemm g{XB_, (const bf16*)(ws + WS_WIN) + (size_t)l * PW * D + (size_t)C_Q * D, D, nullptr, 0};
                gm::DenseOrder S; S.init(T, PW - C_Q, Fp.G, bx_);
                gm::EpiBf16 E{PROJ_ + C_Q, PW, 1.0f};
                REP(1) gm::gemm_phase<gm::EpiBf16, gm::DenseOrder, false>(Fp.lds, Fp.wave, g, S, E);
            }
            const bool split = (Fp.G == 256); const int half = Fp.G >> 1;
            const bool hiw = split && bx_ >= half;
            if (EN(10) && !(l0 && hiw)) REP(10) for (int c = split ? bx_ : Fp.vcu; c < 256; c += l0 ? half : Fp.G) {
                int lane_ = lane_id(); asm volatile("" : "+v"(lane_));
#pragma unroll 1
                for (int gi = 0; gi < 4; ++gi) s5::s5_group<false>(lane_, S5TAB_, PROJ_, S5E_, c, 4 * Fp.wave + gi, nullptr, nullptr);
            }
            if (EN(11)) REP(11) {
                const int clo = l0 ? 12288 : CONV_LO; const int t_lo = !split ? 0 : hiw ? clo : 0, t_hi = !split ? T : hiw ? T : clo, idx = !split ? Fp.vcu : hiw ? bx_ - half : bx_, cnt = split ? half : Fp.G;
#pragma unroll 2
                for (int t = t_lo + idx * NWAVES + Fp.wave; t < t_hi; t += cnt * NWAVES) conv_row(Fp, PROJ_, ka->in[13] + (size_t)l * 3 * GW, MIXG_ + 512, MIX_, t);
            }
            if (EN(12) && (!split || hiw)) REP(12) for (int blk = split ? bx_ - half : Fp.vcu; blk < 128; blk += split ? half : Fp.G)
                sgu::sgu_block(Fp, PROJ_, ka->in[14] + l * GW, ka->in[15] + l * GW, (const bf16*)(ws + WS_SGUW) + (size_t)l * 65536, ka->in[17] + l * 512, MIXG_ + 1024, MIX_, blk);
            if (l == 0) { __syncthreads(); convert_items(Fp, TI_TOTAL - TI_DEFER, TI_TOTAL, gw, NGW); }
            if (BOTH(pb + 1)) GRID_BAR();
        }
        if (EN(2) && IN(pb + 2)) {
            PHASE_ENV();
            if (EN(14)) REP(14) for (int g = Fp.vcu; g < 32; g += Fp.G) { int lane_ = lane_id(); asm volatile("" : "+v"(lane_)); s5::s5_carry_scan_par(S5TAB_, S5E_, S5IN_, g, lane_, Fp.wave, Fp.lds); __syncthreads(); }
            if (EN(13)) {
                int ln_ = lane_id(); asm volatile("" : "+v"(ln_));
                float d1 = ka->in[18][l * 64 + ln_] * ka->in[19][l * 64 + ln_], d2 = ka->in[20][l * 64 + ln_] * ka->in[21][l * 64 + ln_];
                d1 = wave_sum(d1); d2 = wave_sum(d2);
                const float lam_init = (l == 0) ? 0.2f : 0.35550906f;
                const float lam = expf(d1) - expf(d2) + lam_init;
                REP(13) for (int p = Fp.vcu; p < 256; p += Fp.G) { const int h = p >> 6, s = p & 63;
#pragma unroll 1
                    for (int u2 = 0; u2 < 2; ++u2) at::attn_unit(Fp, PROJ_, MIX_, ka->in[23], ka->in[22] + l * 128, h, u2 ? s : 127 - s, lam, 1.0f - lam_init); }
            }
            if (BOTH(pb + 2)) GRID_BAR();
        }
        if (EN(3) && IN(pb + 3)) {
            PHASE_ENV();
            REP(3) for (int c = Fp.vcu; c < 256; c += Fp.G)
                s5::s5_final_chunk(Fp, S5TAB_, PROJ_, S5IN_, (const bf16*)(ws + WS_WGLU) + (size_t)l * GW * GW, MIXG_, MIX_, c);
            if (BOTH(pb + 3)) GRID_BAR();
        }
        if (EN(4) && IN(pb + 4)) {
            PHASE_ENV(); int bx_ = blockIdx.x; asm volatile("" : "+s"(bx_));
            gm::Gemm g{MIX_, (const bf16*)(ws + WS_WOUT) + (size_t)l * D * D, D, nullptr, 0};
            gm::DenseOrder S; S.init(T, D, Fp.G, bx_);
            gm::EpiResBf16 E{YFB_, XB_, D, ALPHA};
            REP(4) gm::gemm_phase<gm::EpiResBf16, gm::DenseOrder, false>(Fp.lds, Fp.wave, g, S, E);
            if (BOTH(pb + 4)) GRID_BAR();
        }
        if (EN(5) && IN(pb + 5)) {
            PHASE_ENV();
            REP(5) for (int tile = Fp.vcu; tile < 256; tile += Fp.G)
                rt::ln_router_tile(Fp, YFB_, ka->in[24] + l * D, ka->in[25] + l * D, X1B_, X1L_, (l >= FP8_FIRST) ? X1Q_ : nullptr, (const bf16*)(ws + WS_RT) + (size_t)l * 2 * NEXP * D, (const bf16*)(ws + WS_RT) + (size_t)l * 2 * NEXP * D + (size_t)NEXP * D,
                                   ka->in[27] + l * NEXP, SELE_, SELW_, SELR_, CNT_, tile);
            if (BOTH(pb + 5)) GRID_BAR();
        }
        if (EN(6) && IN(pb + 6)) {
            PHASE_ENV();
            REP(6) for (int tile = Fp.vcu; tile < 256; tile += Fp.G) sc::scatter_tile(Fp, CNT_, SELE_, SELR_, ROWTOK_, SLOT_, ETAB_, tile);
            if (BOTH(pb + 6)) GRID_BAR();
        }
        if (EN(7) && IN(pb + 7)) {
            PHASE_ENV();
            LAS int* tp = (LAS int*)(Fp.lds + LDS_MISC - 512);
            { int t_ = Fp.wave * 64 + lane_id(); asm volatile("" : "+v"(t_)); if (t_ < 66) tp[t_] = ETAB_[t_]; }
            __syncthreads();
            if (l >= FP8_FIRST) {
                gm::Gemm g{X1Q_, ws + WS_WGU + (size_t)l * NE1 * 1024 * D * 2, D, ROWTOK_, (size_t)1024 * D};
                gm::GroupOrder S{tp, 4, Fp.G, Fp.vcu, 0};
                gm::EpiSwiGlu<(DOWN_FP8 != 0)> E{HB_, 1.0f / W8SCALE};
                REP(7) { S.ecur = 0; gm::gemm_phase<gm::EpiSwiGlu<(DOWN_FP8 != 0)>, gm::GroupOrder, true, true>(Fp.lds, Fp.wave, g, S, E); }
            } else {
                gm::Gemm g{X1B_, ws + WS_WGU + (size_t)l * NE1 * 1024 * D * 2, D, ROWTOK_, (size_t)1024 * D * 2};
                gm::GroupOrder S{tp, 4, Fp.G, Fp.vcu, 0};
                gm::EpiSwiGlu<false> E{HB_, 1.0f};
                REP(7) { S.ecur = 0; gm::gemm_phase<gm::EpiSwiGlu<false>, gm::GroupOrder, true, false>(Fp.lds, Fp.wave, g, S, E); }
            }
            if (BOTH(pb + 7)) GRID_BAR();
        }
        if (EN(8) && IN(pb + 8)) {
            PHASE_ENV();
            LAS int* tp = (LAS int*)(Fp.lds + LDS_MISC - 512);
            { int t_ = Fp.wave * 64 + lane_id(); asm volatile("" : "+v"(t_)); if (t_ < 66) tp[t_] = ETAB_[t_]; }
            __syncthreads();
            if (DOWN_FP8 && l >= FP8_FIRST) {
                gm::Gemm g{HB_, ws + WS_WDN + (size_t)l * NE1 * D * DEXP * 2, DEXP, nullptr, (size_t)D * DEXP};
                gm::GroupOrder S{tp, 8, Fp.G, Fp.vcu, 0};
                gm::EpiStore<true> E{YS_, D, YS8SCALE / W8SCALE};
                REP(8) { S.ecur = 0; gm::gemm_phase<gm::EpiStore<true>, gm::GroupOrder, false, true>(Fp.lds, Fp.wave, g, S, E); }
            } else {
                gm::Gemm g{HB_, ws + WS_WDN + (size_t)l * NE1 * D * DEXP * 2, DEXP, nullptr, (size_t)D * DEXP * 2};
                gm::GroupOrder S{tp, 8, Fp.G, Fp.vcu, 0};
                gm::EpiBf16 E{YS_, D, 1.0f};
                REP(8) { S.ecur = 0; gm::gemm_phase<gm::EpiBf16, gm::GroupOrder, false, false>(Fp.lds, Fp.wave, g, S, E); }
            }
            if (BOTH(pb + 8)) GRID_BAR();
        }
        if (EN(9) && IN(pb + 9)) {
            PHASE_ENV();
            const int sh_base = ETAB_[64] * 256;
            if (DOWN_FP8 && l >= FP8_FIRST) { REP(9) for (int t = gw; t < T; t += NGW) combine_row<true>(Fp, YS_, SLOT_, SELW_, X1B_, ka->in[32] + l * D, ka->in[33] + l * D, ka->out, XB_, sh_base, t, l == DEPTH - 1); }
            else { REP(9) for (int t = gw; t < T; t += NGW) combine_row<false>(Fp, YS_, SLOT_, SELW_, X1B_, ka->in[32] + l * D, ka->in[33] + l * D, ka->out, XB_, sh_base, t, l == DEPTH - 1); }
            if (BOTH(pb + 9)) GRID_BAR();
        }
    }
#undef IN
#undef BOTH
}

extern "C" void kernel_launch(void* const* d_in, const int* in_sizes, int n_in, void* d_out, int out_size, void* d_ws, size_t ws_size, hipStream_t stream) {
    static int grid = 0;
    if (grid == 0) {
        if (n_in != 34 || out_size != T * D || ws_size < WS_END) { fprintf(stderr, "kernel_launch: unexpected shapes (n_in %d, out %d, ws %zu < %zu)\n", n_in, out_size, ws_size, (size_t)WS_END); grid = -1; return; }
        int dev = 0, cus = 0, per_cu = 0;
        if (hipGetDevice(&dev) != hipSuccess || hipDeviceGetAttribute(&cus, hipDeviceAttributeMultiprocessorCount, dev) != hipSuccess) { grid = -1; return; }
        if (hipFuncSetAttribute((const void*)fwd, hipFuncAttributeMaxDynamicSharedMemorySize, LDS_BYTES) != hipSuccess) { fprintf(stderr, "kernel_launch: hipFuncSetAttribute failed\n"); grid = -1; return; }
        if (hipOccupancyMaxActiveBlocksPerMultiprocessor(&per_cu, (const void*)fwd, NTHR, LDS_BYTES) != hipSuccess || per_cu < 1) fprintf(stderr, "kernel_launch: occupancy query says %d\n", per_cu);
        (void)hipGetLastError();
        grid = cus;
    }
    if (grid < 0) return;
    (void)hipMemsetAsync((char*)d_ws + WS_CTL, 0, CTL_ZERO_BYTES, stream);
    Args a{};
    for (int i = 0; i < 34; ++i) a.in[i] = (const float*)d_in[i];
    a.out = (float*)d_out; a.ws = (unsigned char*)d_ws;
#if MK_ONE_LAUNCH
    a.ph_lo = 0; a.ph_hi = NPH;
    hipLaunchKernelGGL(fwd, dim3(grid), dim3(NTHR), LDS_BYTES, stream, a);
#else
    for (int p = 0; p < NPH; ++p) { a.ph_lo = p; a.ph_hi = p + 1; hipLaunchKernelGGL(fwd, dim3(grid), dim3(NTHR), LDS_BYTES, stream, a); }
#endif
}
```
